# Optimizing an MI355X kernel written in HIP

```python
import math
import jax, jax.numpy as jnp
from jax import lax
import numpy as np

D_MODEL = 1024
BATCH = 8
SEQ = 8192
DEPTH = 2

GRID_W = 64
CTX_LEN = 256
N_HEADS = 16
HEAD_DIM = D_MODEL // N_HEADS
WIN_R_MAX = 8
WIN_C = 16
CONV_W = 3
N_MIXERS = 2
N_CONV_LAYERS = (DEPTH + 1) // 2
N_NA_LAYERS = DEPTH // 2
EPS = 1e-6

kernel_name = "hybrid_conv_natten_prefix_dit"


def rms_norm(x, g):
    xf = x.astype(jnp.float32)
    y = xf * lax.rsqrt(jnp.mean(xf * xf, axis=-1, keepdims=True) + EPS)
    return y.astype(x.dtype) * g


def modulation(cvec, w, b):
    m = jax.nn.silu(cvec) @ w + b
    return jnp.split(m, 3, axis=-1)


def dwconv3_centred(u, w):
    up = jnp.pad(u, ((0, 0), (1, 1), (0, 0)))
    return w[0] * up[:, :-2] + w[1] * up[:, 1:-1] + w[2] * up[:, 2:]


def conv_mixer(h, w_in, conv_w, w_out):
    b_g, c_g, u, z = jnp.split(h @ w_in, 4, axis=-1)
    y = b_g * dwconv3_centred(c_g * u, conv_w) * jax.nn.silu(z)
    return y @ w_out


def dense_attention(q, k, v):
    s = jnp.einsum('bqhd,bkhd->bhqk', q, k) * (q.shape[-1] ** -0.5)
    p = jax.nn.softmax(s.astype(jnp.float32), axis=-1).astype(v.dtype)
    return jnp.einsum('bhqk,bkhd->bqhd', p, v)


def neighbourhood_attention(q, k, v, k_ctx, v_ctx, rpb):
    B, L, H, Dh = q.shape
    rows = L // GRID_W
    win_r = min(WIN_R_MAX, rows)
    n_lat = win_r * WIN_C
    qg = (q * (Dh ** -0.5)).reshape(B, rows, GRID_W, H, Dh)
    kg = k.reshape(B, rows, GRID_W, H, Dh)
    vg = v.reshape(B, rows, GRID_W, H, Dh)
    cols = jnp.arange(GRID_W)
    col_start = jnp.clip(cols - WIN_C // 2, 0, GRID_W - WIN_C)
    col_idx = col_start[:, None] + jnp.arange(WIN_C)[None, :]
    dc_idx = col_idx - cols[:, None] + (WIN_C - 1)

    def row_step(args):
        r, q_row = args
        rs = jnp.clip(r - win_r // 2, 0, rows - win_r)
        k_band = lax.dynamic_slice_in_dim(kg, rs, win_r, axis=1)
        v_band = lax.dynamic_slice_in_dim(vg, rs, win_r, axis=1)
        k_win = jnp.take(k_band, col_idx, axis=2)
        v_win = jnp.take(v_band, col_idx, axis=2)
        dr_idx = rs + jnp.arange(win_r) - r + (WIN_R_MAX - 1)
        bias = rpb[:, dr_idx[:, None, None], dc_idx[None, :, :]]
        s_lat = jnp.einsum('bchd,bvcwhd->bhcvw', q_row, k_win) + jnp.transpose(bias, (0, 2, 1, 3))[None]
        s_ctx = jnp.einsum('bchd,bjhd->bhcj', q_row, k_ctx)
        logits = jnp.concatenate([s_lat.reshape(B, H, GRID_W, n_lat), s_ctx], axis=-1)
        p = jax.nn.softmax(logits.astype(jnp.float32), axis=-1).astype(v.dtype)
        p_lat = p[..., :n_lat].reshape(B, H, GRID_W, win_r, WIN_C)
        p_ctx = p[..., n_lat:]
        return (jnp.einsum('bhcvw,bvcwhd->bchd', p_lat, v_win)
                + jnp.einsum('bhcj,bjhd->bchd', p_ctx, v_ctx))

    out = lax.map(row_step, (jnp.arange(rows), jnp.moveaxis(qg, 1, 0)))
    return jnp.moveaxis(out, 0, 1).reshape(B, L, H, Dh)


def setup_inputs(seed: int = 0) -> dict:
    key = jax.random.key(seed)
    ks = jax.random.split(key, 16)
    D = D_MODEL
    s = D ** -0.5
    return {
        "x": jax.random.normal(ks[0], (BATCH, SEQ, D), jnp.float32),
        "c": jax.random.normal(ks[1], (BATCH, D), jnp.float32),
        "ctx": jax.random.normal(ks[2], (BATCH, CTX_LEN, D), jnp.float32),
        "c_ctx": jax.random.normal(ks[3], (D,), jnp.float32),
        "g_pre": 1.0 + 0.1 * jax.random.normal(ks[4], (DEPTH, D), jnp.float32),
        "g_post": 1.0 + 0.1 * jax.random.normal(ks[5], (DEPTH, D), jnp.float32),
        "w_mod": 0.5 * s * jax.random.normal(ks[6], (DEPTH, D, 3 * D), jnp.float32),
        "b_mod": 0.02 * jax.random.normal(ks[7], (DEPTH, 3 * D), jnp.float32),
        "w_in_conv": s * jax.random.normal(ks[8], (N_CONV_LAYERS, D, 4 * D), jnp.float32),
        "conv_w": (CONV_W ** -0.5) * jax.random.normal(ks[9], (N_CONV_LAYERS, CONV_W, D), jnp.float32),
        "w_out_conv": s * jax.random.normal(ks[10], (N_CONV_LAYERS, D, D), jnp.float32),
        "w_in_na": s * jax.random.normal(ks[11], (N_NA_LAYERS, D, 4 * D), jnp.float32),
        "rpb": 0.1 * jax.random.normal(ks[12], (N_NA_LAYERS, N_HEADS, 2 * WIN_R_MAX - 1, 2 * WIN_C - 1), jnp.float32),
        "w_out_na": s * jax.random.normal(ks[13], (N_NA_LAYERS, D, D), jnp.float32),
    }


def reference(x, c, ctx, c_ctx, g_pre, g_post, w_mod, b_mod,
              w_in_conv, conv_w, w_out_conv, w_in_na, rpb, w_out_na):
    B, L, D = x.shape
    Bc, Lc, _ = ctx.shape
    for i in range(DEPTH):
        last = i == DEPTH - 1
        j = i // N_MIXERS
        sh, sc, gt = modulation(c, w_mod[i], b_mod[i])
        sh_c, sc_c, gt_c = modulation(c_ctx, w_mod[i], b_mod[i])
        h = rms_norm(x, g_pre[i]) * (1 + sc[:, None, :]) + sh[:, None, :]
        hc = rms_norm(ctx, g_pre[i]) * (1 + sc_c) + sh_c
        if i % N_MIXERS == 0:
            y = conv_mixer(h, w_in_conv[j], conv_w[j], w_out_conv[j])
            if not last:
                yc = conv_mixer(hc, w_in_conv[j], conv_w[j], w_out_conv[j])
        else:
            wi = w_in_na[j]
            q, k, v, z = jnp.split(h @ wi, 4, axis=-1)
            k_c, v_c = jnp.split(hc @ wi[:, D:3 * D], 2, axis=-1)
            heads = lambda t, n: t.reshape(B, n, N_HEADS, HEAD_DIM)
            k_c, v_c = heads(k_c, Lc), heads(v_c, Lc)
            o = neighbourhood_attention(heads(q, L), heads(k, L), heads(v, L), k_c, v_c, rpb[j])
            y = (jax.nn.silu(z) * o.reshape(B, L, D)) @ w_out_na[j]
            if not last:
                q_c = heads(hc @ wi[:, :D], Lc)
                z_c = hc @ wi[:, 3 * D:]
                oc = dense_attention(q_c, k_c, v_c)
                yc = (jax.nn.silu(z_c) * oc.reshape(Bc, Lc, D)) @ w_out_na[j]
        x = x + gt[:, None, :] * rms_norm(y, g_post[i])
        if not last:
            ctx = ctx + gt_c * rms_norm(yc, g_post[i])
    return x
```

```cpp
#include <hip/hip_runtime.h>
#include <cstdio>
#include <cstdint>
namespace pg8 {
#define PG8_LAS __attribute__((address_space(3)))
typedef unsigned short bf16_t;
typedef short bf16x8 __attribute__((ext_vector_type(8)));
typedef float f32x4 __attribute__((ext_vector_type(4)));
typedef unsigned u32x4 __attribute__((ext_vector_type(4)));
constexpr int BM = 256, BK = 64, HALF = 128, HTB = HALF * BK * 2  , STAGE_BYTES = 8 * HTB, NXCD = 8, WGM = 8;

__host__ __device__ __forceinline__ int lds_byte(int r, int c) { const int st = (r >> 4) * 2 + (c >> 5), rr = r & 15, cc = c & 31, ob = rr * 64 + cc * 2; return st * 1024 + (ob ^ (((ob >> 9) & 1) << 5)); }
__host__ __device__ __forceinline__ void stage_rc(int b, int& R, int& C) { const int st = b / 1024, sb = b % 1024, swz = sb ^ (((sb >> 9) & 1) << 5); R = (st >> 1) * 16 + swz / 64; C = (st & 1) * 32 + (swz % 64) / 2; }
__host__ __device__ __forceinline__ int perm32(int rho) { const int n = rho >> 4, i = rho & 15; return 8 * (i >> 2) + 4 * n + (i & 3); }

struct Unit { int pm, pn; };
struct Gemm { const bf16_t* A; const bf16_t* Bt; int M, N, K; };

struct StaticOrder {
    int nM, nN, nwg, G, c;
    __host__ __device__ void init(int M, int N, int G_, int c_) { nM = M / BM; nN = N / BM; nwg = nM * nN; G = G_; c = c_; }
    __host__ __device__ bool next(int i, Unit& u) const {
        const long L = (long)i * G + c; if (L >= nwg) return false;
        int wgid = (int)L; { const int q = nwg / NXCD, r = nwg % NXCD, xcd = wgid % NXCD, off = wgid / NXCD; wgid = (xcd < r ? xcd * (q + 1) : r * (q + 1) + (xcd - r) * q) + off; }
        const int nig = WGM * nN, gid = wgid / nig, fm = gid * WGM, gsz = (nM - fm) < WGM ? (nM - fm) : WGM;
        u.pm = fm + ((wgid % nig) % gsz); u.pn = (wgid % nig) / gsz; return true;
    }
    __device__ __forceinline__ void a_ready(const Unit&) const {}
    __device__ __forceinline__ void done(const Unit&) const {}
};

__device__ __forceinline__ unsigned cvt_pk_bf16(float lo, float hi) { unsigned r; asm volatile("v_cvt_pk_bf16_f32 %0, %1, %2" : "=v"(r) : "v"(lo), "v"(hi)); return r; }
typedef unsigned u32x2 __attribute__((ext_vector_type(2)));
__device__ __forceinline__ float silu_f(float z) { return z * __builtin_amdgcn_rcpf(1.0f + __expf(-z)); }

struct EpiBf16Split {
    static constexpr bool PERM = true, AFTER_DRAIN = false;
    bf16_t* O; int ldc; int split_cols; size_t split_stride; float scale0;
    __device__ __forceinline__ void operator()(const f32x4 (&acc)[2][2][4][2], const Unit& u, int wr, int wc, int fr, int fq) const {
        const int row0 = u.pm * BM + wr * 64 + fr; int colt = u.pn * BM; bf16_t* base = O;
        float sc = 1.f; { const int t = colt / split_cols; base += (size_t)t * split_stride; colt -= t * split_cols; if (t == 0) sc = scale0; }
        const int col0 = colt + wc * 32 + 8 * fq;
#pragma unroll
        for (int ai = 0; ai < 2; ++ai)
#pragma unroll
            for (int m = 0; m < 4; ++m) { bf16_t* rowp = base + (size_t)(row0 + ai * HALF + m * 16) * ldc + col0;
#pragma unroll
                for (int bj = 0; bj < 2; ++bj) { const f32x4 v0 = acc[ai][bj][m][0] * sc, v1 = acc[ai][bj][m][1] * sc;
                    u32x4 w; w.x = cvt_pk_bf16(v0[0], v0[1]); w.y = cvt_pk_bf16(v0[2], v0[3]); w.z = cvt_pk_bf16(v1[0], v1[1]); w.w = cvt_pk_bf16(v1[2], v1[3]);
                    *(u32x4*)(rowp + bj * HALF) = w; } }
    }
};
struct EpiGate {
    static constexpr bool PERM = false, AFTER_DRAIN = false;
    bf16_t* P; bf16_t* G;
    __device__ __forceinline__ void operator()(const f32x4 (&acc)[2][2][4][2], const Unit& u, int wr, int wc, int fr, int fq) const {
        const int row0 = u.pm * BM + wr * 64 + fr, ch0 = u.pn * 64 + wc * 16 + 4 * fq;
#pragma unroll
        for (int ai = 0; ai < 2; ++ai)
#pragma unroll
            for (int m = 0; m < 4; ++m) { const size_t off = (size_t)(row0 + ai * HALF + m * 16) * 1024 + ch0;
                const f32x4 bg = acc[ai][0][m][0], cg = acc[ai][0][m][1], uu = acc[ai][1][m][0], zz = acc[ai][1][m][1];
                const f32x4 p = cg * uu; f32x4 g;
#pragma unroll
                for (int j = 0; j < 4; ++j) g[j] = bg[j] * silu_f(zz[j]);
                u32x2 wp, wg; wp.x = cvt_pk_bf16(p[0], p[1]); wp.y = cvt_pk_bf16(p[2], p[3]); wg.x = cvt_pk_bf16(g[0], g[1]); wg.y = cvt_pk_bf16(g[2], g[3]);
                *(u32x2*)(P + off) = wp; *(u32x2*)(G + off) = wg; }
    }
};
struct EpiF32 {
    static constexpr bool PERM = false, AFTER_DRAIN = false;
    float* O; int ldc;
    __device__ __forceinline__ void operator()(const f32x4 (&acc)[2][2][4][2], const Unit& u, int wr, int wc, int fr, int fq) const {
        const int row0 = u.pm * BM + wr * 64 + fr, col0 = u.pn * BM + wc * 32 + 4 * fq;
#pragma unroll
        for (int ai = 0; ai < 2; ++ai)
#pragma unroll
            for (int m = 0; m < 4; ++m) { float* rowp = O + (size_t)(row0 + ai * HALF + m * 16) * ldc + col0;
#pragma unroll
                for (int bj = 0; bj < 2; ++bj)
#pragma unroll
                    for (int n = 0; n < 2; ++n) *(f32x4*)(rowp + bj * HALF + n * 16) = acc[ai][bj][m][n]; }
    }
};
template <class Epi, class Sched, bool ALIGN_EPI = false, bool SP2 = false>
__device__ __forceinline__ void gemm_phase(PG8_LAS unsigned char* lds, const Gemm g, const Sched& S, const Epi& E) {
    const int tid = threadIdx.x, wid = __builtin_amdgcn_readfirstlane(tid >> 6), lane = tid & 63, wr = wid >> 2, wc = wid & 3, fr = lane & 15, fq = lane >> 4;
    const int K = g.K, nt = K / BK;
    unsigned voffA[2], voffB[2];
#pragma unroll
    for (int i = 0; i < 2; ++i) { int R, C; stage_rc(tid * 16 + i * 8192, R, C); const int Rb = Epi::PERM ? ((R & ~31) + perm32(R & 31)) : R;
        voffA[i] = (unsigned)(R * K + C) * 2u; voffB[i] = (unsigned)(Rb * K + C) * 2u; }
    const size_t kstep = (size_t)(BK * 2);
    const size_t hstep = (size_t)HALF * K * 2;
    const size_t tstep = 2 * hstep;
    const unsigned ldsw = (unsigned)wid * 1024u;
    const int aoff = lds_byte(wr * 64 + fr, fq * 8), boff = lds_byte(wc * 32 + fr, fq * 8);
#define PG8_SA(b, h) (((b) * 2 + (h)) * HTB)
#define PG8_SB(b, h) ((4 + (b) * 2 + (h)) * HTB)
#define PG8_STAGE(bufoff, gbase, voff) do { _Pragma("unroll") for (int _i = 0; _i < 2; ++_i) \
        __builtin_amdgcn_global_load_lds((const unsigned*)((const char*)(gbase) + (voff)[_i]), (PG8_LAS unsigned*)(lds + (bufoff) + ldsw + _i * 8192), 16, 0, 0); } while (0)
#define PG8_LDA(dst, b, h) do { _Pragma("unroll") for (int m = 0; m < 4; ++m) _Pragma("unroll") for (int k = 0; k < 2; ++k) dst[m][k] = *(const PG8_LAS bf16x8*)(lds + PG8_SA(b, h) + aoff + m * 2048 + k * 1024); } while (0)
#define PG8_LDB(dst, b, h) do { _Pragma("unroll") for (int n = 0; n < 2; ++n) _Pragma("unroll") for (int k = 0; k < 2; ++k) dst[n][k] = *(const PG8_LAS bf16x8*)(lds + PG8_SB(b, h) + boff + n * 2048 + k * 1024); } while (0)
#define PG8_MMA(ai, bj, At, Bt) do { __builtin_amdgcn_s_setprio(1); _Pragma("unroll") for (int m = 0; m < 4; ++m) _Pragma("unroll") for (int n = 0; n < 2; ++n) _Pragma("unroll") for (int k = 0; k < 2; ++k) \
        acc[ai][bj][m][n] = __builtin_amdgcn_mfma_f32_16x16x32_bf16(Bt[n][k], At[m][k], acc[ai][bj][m][n], 0, 0, 0); __builtin_amdgcn_s_setprio(0); } while (0)
#define PG8_WAIT_V(n) asm volatile("s_waitcnt vmcnt(" #n ")" ::: "memory")
#define PG8_WAIT_L(n) asm volatile("s_waitcnt lgkmcnt(" #n ")" ::: "memory")
#define PG8_BAR __builtin_amdgcn_s_barrier()
#define PG8_SCHED __builtin_amdgcn_sched_barrier(0)
    Unit cur, nxt; int ui = 0;
    if (!S.next(0, cur)) return;
    f32x4 acc[2][2][4][2];
#pragma unroll
    for (int a = 0; a < 2; ++a)
#pragma unroll
        for (int b = 0; b < 2; ++b)
#pragma unroll
            for (int m = 0; m < 4; ++m)
#pragma unroll
                for (int n = 0; n < 2; ++n) acc[a][b][m][n] = (f32x4){0.f, 0.f, 0.f, 0.f};
    bf16x8 At[4][2], B0[2][2], B1[2][2];
    const char* cA = (const char*)g.A + (size_t)cur.pm * tstep; const char* cB = (const char*)g.Bt + (size_t)cur.pn * tstep;
    S.a_ready(cur);
    if constexpr (SP2) {
        PG8_STAGE(PG8_SB(0, 0), cB, voffB); PG8_STAGE(PG8_SB(0, 1), cB + hstep, voffB); PG8_STAGE(PG8_SA(0, 0), cA, voffA); PG8_STAGE(PG8_SA(0, 1), cA + hstep, voffA);
        if (wr == 1) PG8_BAR;
        PG8_WAIT_V(2); PG8_BAR;
        PG8_STAGE(PG8_SB(1, 0), cB + kstep, voffB); PG8_STAGE(PG8_SA(1, 0), cA + kstep, voffA); PG8_STAGE(PG8_SB(1, 1), cB + hstep + kstep, voffB);
        PG8_WAIT_V(6); PG8_BAR;
    } else {
        PG8_STAGE(PG8_SB(0, 0), cB, voffB); PG8_STAGE(PG8_SA(0, 0), cA, voffA); PG8_STAGE(PG8_SB(0, 1), cB + hstep, voffB); PG8_STAGE(PG8_SA(0, 1), cA + hstep, voffA);
        if (wr == 1) PG8_BAR;
        PG8_WAIT_V(4); PG8_BAR;
        PG8_STAGE(PG8_SB(1, 0), cB + kstep, voffB); PG8_STAGE(PG8_SA(1, 0), cA + kstep, voffA); PG8_STAGE(PG8_SB(1, 1), cB + hstep + kstep, voffB);
        PG8_WAIT_V(6); PG8_BAR;
    }
    for (;;) {
        const bool has_next = S.next(ui + 1, nxt);
        const char* nA = has_next ? (const char*)g.A + (size_t)nxt.pm * tstep : cA; const char* nB = has_next ? (const char*)g.Bt + (size_t)nxt.pn * tstep : cB;
        for (int t = 0; t < nt; t += 2) {
            const bool last = (t == nt - 2);
            const char* a1 = cA + (size_t)(t + 1) * kstep;
            const char* a2 = last ? nA : cA + (size_t)(t + 2) * kstep; const char* b2 = last ? nB : cB + (size_t)(t + 2) * kstep;
            const char* a3 = a2 + kstep; const char* b3 = b2 + kstep;
            if (last && has_next) S.a_ready(nxt);
            if constexpr (SP2) {
            PG8_LDB(B0, 0, 0); PG8_LDB(B1, 0, 1); PG8_SCHED; PG8_LDA(At, 0, 0); PG8_STAGE(PG8_SA(1, 1), a1 + hstep, voffA);
            PG8_WAIT_V(8); PG8_WAIT_L(0); PG8_BAR; PG8_MMA(0, 0, At, B0); PG8_MMA(0, 1, At, B1); PG8_BAR; PG8_SCHED;
            PG8_LDA(At, 0, 1); PG8_STAGE(PG8_SB(0, 0), b2, voffB); PG8_STAGE(PG8_SB(0, 1), b2 + hstep, voffB); PG8_STAGE(PG8_SA(0, 0), a2, voffA);
            PG8_WAIT_V(8); PG8_WAIT_L(0); PG8_BAR; PG8_MMA(1, 0, At, B0); PG8_MMA(1, 1, At, B1); PG8_BAR; PG8_SCHED;
            PG8_LDB(B0, 1, 0); PG8_LDB(B1, 1, 1); PG8_SCHED; PG8_LDA(At, 1, 0); PG8_STAGE(PG8_SA(0, 1), a2 + hstep, voffA);
            PG8_WAIT_V(8); PG8_WAIT_L(0); PG8_BAR; PG8_MMA(0, 0, At, B0); PG8_MMA(0, 1, At, B1); PG8_BAR; PG8_SCHED;
            PG8_LDA(At, 1, 1); PG8_STAGE(PG8_SB(1, 0), b3, voffB); PG8_STAGE(PG8_SB(1, 1), b3 + hstep, voffB); PG8_STAGE(PG8_SA(1, 0), a3, voffA);
            PG8_WAIT_V(8); PG8_WAIT_L(0); PG8_BAR; PG8_MMA(1, 0, At, B0); PG8_MMA(1, 1, At, B1); PG8_BAR; PG8_SCHED;
            } else {
            PG8_LDB(B0, 0, 0); PG8_SCHED; PG8_LDA(At, 0, 0); PG8_STAGE(PG8_SA(1, 1), a1 + hstep, voffA);
            PG8_WAIT_L(8); PG8_BAR; PG8_WAIT_L(0); PG8_MMA(0, 0, At, B0); PG8_BAR; PG8_SCHED;
            PG8_LDB(B1, 0, 1); PG8_STAGE(PG8_SB(0, 0), b2, voffB);
            PG8_BAR; PG8_WAIT_L(0); PG8_MMA(0, 1, At, B1); PG8_BAR;
            PG8_LDA(At, 0, 1); PG8_STAGE(PG8_SA(0, 0), a2, voffA);
            PG8_BAR; PG8_WAIT_L(0); PG8_MMA(1, 0, At, B0); PG8_BAR; PG8_SCHED;
            PG8_STAGE(PG8_SB(0, 1), b2 + hstep, voffB);
            PG8_WAIT_V(6); PG8_BAR; PG8_MMA(1, 1, At, B1); PG8_BAR;
            PG8_LDB(B0, 1, 0); PG8_SCHED; PG8_LDA(At, 1, 0); PG8_STAGE(PG8_SA(0, 1), a2 + hstep, voffA);
            PG8_WAIT_L(8); PG8_BAR; PG8_WAIT_L(0); PG8_MMA(0, 0, At, B0); PG8_BAR; PG8_SCHED;
            PG8_LDB(B1, 1, 1); PG8_STAGE(PG8_SB(1, 0), b3, voffB);
            PG8_BAR; PG8_WAIT_L(0); PG8_MMA(0, 1, At, B1); PG8_BAR;
            PG8_LDA(At, 1, 1); PG8_STAGE(PG8_SA(1, 0), a3, voffA);
            PG8_BAR; PG8_WAIT_L(0); PG8_MMA(1, 0, At, B0); PG8_BAR; PG8_SCHED;
            PG8_STAGE(PG8_SB(1, 1), b3 + hstep, voffB);
            PG8_WAIT_V(6); PG8_BAR; PG8_MMA(1, 1, At, B1); PG8_BAR;
            }
        }
        if constexpr (ALIGN_EPI) { if (wr == 0) PG8_BAR; }
        if constexpr (!Epi::AFTER_DRAIN) { E(acc, cur, wr, wc, fr, fq); S.done(cur); }
        if (!has_next) break;
#pragma unroll
        for (int a = 0; a < 2; ++a)
#pragma unroll
            for (int b = 0; b < 2; ++b)
#pragma unroll
                for (int m = 0; m < 4; ++m)
#pragma unroll
                    for (int n = 0; n < 2; ++n) acc[a][b][m][n] = (f32x4){0.f, 0.f, 0.f, 0.f};
        cur = nxt; cA = nA; cB = nB; ++ui;
        if constexpr (ALIGN_EPI) { if (wr == 1) PG8_BAR; }
    }
    PG8_WAIT_V(0);
    if constexpr (!ALIGN_EPI) { if (wr == 0) PG8_BAR; }
    PG8_BAR;
    if constexpr (Epi::AFTER_DRAIN) { E.fused(acc, cur, wr, wc, fr, fq, lds, wid, lane); S.done(cur); }
#undef PG8_SA
#undef PG8_SB
#undef PG8_STAGE
#undef PG8_LDA
#undef PG8_LDB
#undef PG8_MMA
#undef PG8_WAIT_V
#undef PG8_WAIT_L
#undef PG8_BAR
#undef PG8_SCHED
}
}
#ifndef PG8_SP2
#define PG8_SP2 true
#endif
#ifndef PG8_ALIGN
#define PG8_ALIGN true
#endif
constexpr int NWAVES = 8;
#ifndef MK_N_LAUNCHES
#define MK_N_LAUNCHES 1
#endif
constexpr int N_PHASES = 10;
constexpr int N_LAUNCHES = MK_N_LAUNCHES;
static_assert(N_LAUNCHES == 1 || N_LAUNCHES == N_PHASES, "MK_N_LAUNCHES is 1 or N_PHASES");

constexpr int NB = 8, SEQ = 8192, D = 1024, LC = 256, NH = 16, HD = 64, GW = 64, GROWS = SEQ / GW;
constexpr int M_LAT = NB * SEQ, M_CTX = NB * LC, M_ALL = M_LAT + M_CTX;
constexpr int N4 = 4 * D;
constexpr float EPS = 1e-6f;
constexpr float LOG2E = 1.4426950408889634f;
constexpr float QSCALE = 0.125f * LOG2E;
static_assert(M_ALL % 256 == 0, "rows");

constexpr size_t MiB = 1u << 20;
constexpr size_t WS_CTL = 0, CTL_ZERO_BYTES = 1 * MiB;
constexpr size_t WS_MOD = 1 * MiB;
constexpr size_t WS_W1T = 2 * MiB, WS_W2T = 10 * MiB, WS_W3T = 12 * MiB, WS_W4T = 20 * MiB;
constexpr size_t WS_H = 32 * MiB;
constexpr size_t RSZ = (size_t)M_ALL * D * 2;
constexpr size_t WS_R1 = WS_H + RSZ, WS_R2 = WS_R1 + RSZ, WS_R3 = WS_R2 + RSZ, WS_R4 = WS_R3 + RSZ;
constexpr size_t WS_X1 = WS_R4 + RSZ;
constexpr size_t WS_END = WS_X1 + (size_t)M_LAT * D * 4;
static_assert(RSZ == 132 * MiB && WS_END == 948 * MiB, "d_ws map");
constexpr int CW_TMO = 0, CW_CODE = 1;
constexpr int CW_BAR = 4096;

constexpr int RING_OFF = 0, RING_BYTES = 131072;
constexpr int LDSCTL_OFF = RING_BYTES, MISC_OFF = LDSCTL_OFF + 320;
constexpr int LDS_BYTES = 147456;
static_assert(MISC_OFF + 128 <= LDS_BYTES, "LDS map");

#define GAS __attribute__((address_space(1)))
#define LAS __attribute__((address_space(3)))
typedef unsigned short bf16;
typedef unsigned v4u __attribute__((ext_vector_type(4)));
typedef float f32x4 __attribute__((ext_vector_type(4)));
typedef short bf16x8 __attribute__((ext_vector_type(8)));
typedef GAS unsigned gu32;
typedef GAS unsigned long long gu64;
#define RLX_AGENT __ATOMIC_RELAXED, __HIP_MEMORY_SCOPE_AGENT
#define LDS_WAIT() asm volatile("s_waitcnt lgkmcnt(0)" ::: "memory")
#define VM_WAIT() asm volatile("s_waitcnt vmcnt(0)" ::: "memory")
__device__ __forceinline__ unsigned long long rt() { return __builtin_amdgcn_s_memrealtime(); }
__device__ __forceinline__ unsigned f2bf(float f) { unsigned u = __builtin_bit_cast(unsigned, f); return (u + 0x7fffu + ((u >> 16) & 1u)) >> 16; }
__device__ __forceinline__ unsigned pk2(float lo, float hi) { return f2bf(lo) | (f2bf(hi) << 16); }

#define XB_TMO      128
#define XB_XCNT(j)  (256  + 64 * (j))
#define XB_XSUB(j)  (1280 + 64 * (j))
#define XB_XGEN(j)  (2304 + 64 * (j))
#define XB_TOP      3328
#define XB_TOPGEN   3392
#define XCD_BAR_WORDS 3456
#define XB_SPIN_CAP (1u << 18)

__device__ __forceinline__ unsigned xb_ld(unsigned* p)              { return __hip_atomic_load(p, __ATOMIC_RELAXED, __HIP_MEMORY_SCOPE_AGENT); }
__device__ __forceinline__ unsigned xb_add(unsigned* p, unsigned v) { return __hip_atomic_fetch_add(p, v, __ATOMIC_RELAXED, __HIP_MEMORY_SCOPE_AGENT); }
__device__ __forceinline__ unsigned xb_xcc_id() { return (unsigned)__builtin_amdgcn_s_getreg((3 << 11) | 20) & 0xFu; }
#define XB_SPIN(cond, bar) do { unsigned _sp = 0; while (cond) { __builtin_amdgcn_s_sleep(1); \
    if ((++_sp & 255u) == 0u) { if (xb_ld(&(bar)[XB_TMO])) break; if (_sp > XB_SPIN_CAP) { atomicAdd(&(bar)[XB_TMO], 1u); break; } } } } while (0)

struct XcdBarrier {
    unsigned* bar; unsigned x;
    volatile LAS unsigned* st;
};

__device__ __forceinline__ XcdBarrier xcd_barrier_post(unsigned* bar, volatile LAS unsigned* st) {
    XcdBarrier b; b.bar = bar; b.x = xb_xcc_id(); b.st = st;
    if (threadIdx.x == 0) (void)xb_add(&bar[XB_XCNT(b.x)], 1u);
    return b;
}
__device__ __forceinline__ void xcd_barrier_complete(unsigned* bar, unsigned x, unsigned& nloc, unsigned& nx) {
    const unsigned G = gridDim.x * gridDim.y * gridDim.z;
    unsigned sum, cnt, mine, sp = 0u;
    for (;;) {
        sum = 0u; cnt = 0u; mine = 0u;
#pragma unroll
        for (unsigned j = 0; j < 16; ++j) { const unsigned c = xb_ld(&bar[XB_XCNT(j)]); sum += c; cnt += (c > 0u) ? 1u : 0u; mine = (j == x) ? c : mine; }
        if (sum == G) break;
        __builtin_amdgcn_s_sleep(1);
        if ((++sp & 255u) == 0u) { if (xb_ld(&bar[XB_TMO])) break; if (sp > XB_SPIN_CAP) { atomicAdd(&bar[XB_TMO], 1u); break; } }
    }
    nloc = mine > 0u ? mine : 1u; nx = cnt > 0u ? cnt : 1u;
}

__device__ __forceinline__ void xcd_barrier(const XcdBarrier& b) {
    asm volatile("s_waitcnt vmcnt(0)" ::: "memory");
    __syncthreads();
    if (threadIdx.x == 0) {
        unsigned* bar = b.bar;
        __builtin_amdgcn_s_waitcnt(0);
        unsigned nloc = b.st[0], nx = b.st[1];
        if (nloc == 0u) { xcd_barrier_complete(bar, b.x, nloc, nx); b.st[0] = nloc; b.st[1] = nx; }
        const unsigned old = xb_add(&bar[XB_XSUB(b.x)], 1u);
        const unsigned gen = old / nloc;
        if (old + 1u == (gen + 1u) * nloc) {
            __builtin_amdgcn_fence(__ATOMIC_RELEASE, "agent");
            asm volatile("s_waitcnt vmcnt(0)" ::: "memory");
            const unsigned og = xb_add(&bar[XB_TOP], 1u);
            const unsigned tg = og / nx;
            if (og + 1u == (tg + 1u) * nx) xb_add(&bar[XB_TOPGEN], 1u);
            else XB_SPIN(xb_ld(&bar[XB_TOPGEN]) == tg, bar);
            __builtin_amdgcn_fence(__ATOMIC_ACQUIRE, "agent");
            xb_add(&bar[XB_XGEN(b.x)], 1u);
            asm volatile("s_waitcnt vmcnt(0)" ::: "memory");
        } else {
            XB_SPIN(xb_ld(&bar[XB_XGEN(b.x)]) == gen, bar);
            __builtin_amdgcn_fence(__ATOMIC_ACQUIRE, "agent");
            asm volatile("s_waitcnt vmcnt(0)" ::: "memory");
        }
    }
    __syncthreads();
}
struct Frame {
    LAS unsigned char* lds;
    volatile LAS unsigned* MISC;
    gu32* ctl;
    int tid, lane, wave;
    int vcu, G;
    const float *x, *c, *ctx, *c_ctx, *g_pre, *g_post, *w_mod, *b_mod, *w_in_conv, *conv_w, *w_out_conv, *w_in_na, *rpb, *w_out_na;
    float* out;
    float* MOD; bf16 *W1T, *W2T, *W3T, *W4T, *H, *R1, *R2, *R3, *R4; float* X1;
};
__device__ __forceinline__ float wave_sum(float v) {
#pragma unroll
    for (int o = 1; o < 64; o <<= 1) v += __shfl_xor(v, o);
    return v;
}
__device__ __forceinline__ float bf_lo(unsigned w) { return __uint_as_float(w << 16); }
__device__ __forceinline__ float bf_hi(unsigned w) { return __uint_as_float(w & 0xffff0000u); }
__device__ __forceinline__ float silu_f(float z) { return z * __builtin_amdgcn_rcpf(1.0f + __expf(-z)); }

template <int MODE> __device__ __forceinline__ int w_dest_row(int n) {
    if (MODE == 0) return n;
    const int s = n >> 10, ch = n & 1023, pn = ch >> 6, t = ch & 63;
    return 256 * pn + 128 * (s >> 1) + 32 * (t >> 4) + 16 * (s & 1) + 4 * ((t >> 2) & 3) + (t & 3);
}
template <int MODE> __device__ __forceinline__ void p0_transpose_item(const float* W, int K, int N, bf16* WT, LAS float* scr, int item, int lane) {
    const int nblk = N / 32, kb = item / nblk, nb = item % nblk, k0 = 64 * kb, n0 = 32 * nb;
#pragma unroll 8
    for (int i = 0; i < 32; ++i) { const int kk = 2 * i + (lane >> 5); scr[kk * 33 + (lane & 31)] = W[(size_t)(k0 + kk) * N + n0 + (lane & 31)]; }
    LDS_WAIT(); asm volatile("" ::: "memory");
    const int c = lane & 7;
#pragma unroll
    for (int j = 0; j < 4; ++j) { const int n = (lane >> 3) + 8 * j; const LAS float* s = scr + (8 * c) * 33 + n;
        v4u o; o.x = pk2(s[0 * 33], s[1 * 33]); o.y = pk2(s[2 * 33], s[3 * 33]); o.z = pk2(s[4 * 33], s[5 * 33]); o.w = pk2(s[6 * 33], s[7 * 33]);
        *(GAS v4u*)(WT + (size_t)w_dest_row<MODE>(n0 + n) * K + k0 + 8 * c) = o; }
    LDS_WAIT(); asm volatile("" ::: "memory");
}
__device__ __forceinline__ void p0_prologue(Frame& F) {
    constexpr int MOD_ITEMS = 2 * (3 * D / 64);
    if ((int)blockIdx.x < MOD_ITEMS) {
        LAS float* stab = (LAS float*)(F.lds + RING_OFF);
        LAS float* red = (LAS float*)(F.lds + RING_OFF + 9 * D * 4);
        for (int o = F.tid; o < 9 * D; o += NWAVES * 64) { const int v = o >> 10, k = o & 1023; const float cv = (v < 8) ? F.c[v * D + k] : F.c_ctx[k]; stab[o] = silu_f(cv); }
        __syncthreads();
        for (int it = blockIdx.x; it < MOD_ITEMS; it += F.G) {
            const int i = it / 48, n0 = (it % 48) * 64;
            const float* W = F.w_mod + (size_t)i * D * 3 * D + n0 + F.lane;
            float acc[9];
#pragma unroll
            for (int v = 0; v < 9; ++v) acc[v] = 0.f;
            const int k0 = F.wave * 128;
#pragma unroll 16
            for (int k = k0; k < k0 + 128; ++k) { const float w = W[(size_t)k * (3 * D)];
#pragma unroll
                for (int v = 0; v < 9; ++v) acc[v] += stab[v * D + k] * w; }
#pragma unroll
            for (int v = 0; v < 9; ++v) red[(F.wave * 9 + v) * 64 + F.lane] = acc[v];
            __syncthreads();
            for (int o = F.tid; o < 9 * 64; o += NWAVES * 64) { const int v = o >> 6, l = o & 63; float s = 0.f;
#pragma unroll
                for (int w = 0; w < NWAVES; ++w) s += red[(w * 9 + v) * 64 + l];
                F.MOD[(size_t)(i * 9 + v) * (3 * D) + n0 + l] = s + F.b_mod[i * 3 * D + n0 + l]; }
            __syncthreads();
        }
    }
    LAS float* scr = (LAS float*)(F.lds + RING_OFF + F.wave * 16384);
    const int gw = F.vcu * NWAVES + F.wave, NGW = F.G * NWAVES;
    constexpr int I_IN = (D / 64) * (N4 / 32), I_OUT = (D / 64) * (D / 32);
    constexpr int NITEMS = 2 * I_IN + 2 * I_OUT;
    for (int it = gw; it < NITEMS; it += NGW) {
        int r = it;
        if (r < I_IN) { p0_transpose_item<1>(F.w_in_conv, D, N4, F.W1T, scr, r, F.lane); continue; } r -= I_IN;
        if (r < I_IN) { p0_transpose_item<0>(F.w_in_na, D, N4, F.W3T, scr, r, F.lane); continue; } r -= I_IN;
        if (r < I_OUT) { p0_transpose_item<0>(F.w_out_conv, D, D, F.W2T, scr, r, F.lane); continue; } r -= I_OUT;
        p0_transpose_item<0>(F.w_out_na, D, D, F.W4T, scr, r, F.lane);
    }
}
__device__ __forceinline__ const float* in_row(const Frame& F, int m) { return (m < M_LAT) ? F.x + (size_t)m * D : F.ctx + (size_t)(m - M_LAT) * D; }
__device__ __forceinline__ int mod_vec(int m) { return (m < M_LAT) ? (m >> 13) : 8; }
__device__ __forceinline__ void mod_store_bf16(const Frame& F, const f32x4 (&v)[4], float rstd, const float* gpre, const float* md, bf16* orow) {
    GAS unsigned long long* o8 = (GAS unsigned long long*)orow + F.lane;
#pragma unroll
    for (int j = 0; j < 4; ++j) { const int col = 4 * (F.lane + 64 * j);
        const f32x4 g = *(const f32x4*)(gpre + col), sh = *(const f32x4*)(md + col), sc = *(const f32x4*)(md + D + col);
        const f32x4 hv = (v[j] * rstd) * g * (sc + 1.0f) + sh;
        o8[64 * j] = (unsigned long long)pk2(hv.x, hv.y) | ((unsigned long long)pk2(hv.z, hv.w) << 32); }
}
__device__ __forceinline__ float sumsq4(const f32x4 (&v)[4]) { float s = 0.f;
#pragma unroll
    for (int j = 0; j < 4; ++j) s += (v[j].x * v[j].x + v[j].y * v[j].y) + (v[j].z * v[j].z + v[j].w * v[j].w);
    return s; }
__device__ __forceinline__ void p1_h0(Frame& F) {
    const int gw = F.vcu * NWAVES + F.wave, NGW = F.G * NWAVES;
    for (int m = gw; m < M_ALL; m += NGW) {
        const GAS f32x4* xr = (const GAS f32x4*)in_row(F, m) + F.lane; f32x4 v[4];
#pragma unroll
        for (int j = 0; j < 4; ++j) v[j] = xr[64 * j];
        const float rstd = __builtin_amdgcn_rsqf(wave_sum(sumsq4(v)) * (1.f / D) + EPS);
        mod_store_bf16(F, v, rstd, F.g_pre, F.MOD + (size_t)mod_vec(m) * (3 * D), F.H + (size_t)m * D);
    }
}
__device__ __forceinline__ void p3_conv(Frame& F) {
    const int gw = F.vcu * NWAVES + F.wave, NGW = F.G * NWAVES;
    const bf16 *P = F.R1, *Gt = F.R2; bf16* Y = F.R3;
    for (int m = gw; m < M_ALL; m += NGW) {
        const bool lat = m < M_LAT; const int pos = lat ? (m & (SEQ - 1)) : ((m - M_LAT) & (LC - 1)); const int len = lat ? SEQ : LC;
        const bool hasp = pos > 0, hasn = pos < len - 1;
#pragma unroll
        for (int j = 0; j < 2; ++j) { const int ch0 = 8 * (F.lane + 64 * j); const size_t off = (size_t)m * D + ch0;
            const v4u z4 = (v4u){0u, 0u, 0u, 0u};
            const v4u pc = *(const GAS v4u*)(P + off), gg = *(const GAS v4u*)(Gt + off);
            const v4u pp = hasp ? *(const GAS v4u*)(P + off - D) : z4, pn = hasn ? *(const GAS v4u*)(P + off + D) : z4;
            const f32x4 w0a = *(const f32x4*)(F.conv_w + ch0), w0b = *(const f32x4*)(F.conv_w + ch0 + 4);
            const f32x4 w1a = *(const f32x4*)(F.conv_w + D + ch0), w1b = *(const f32x4*)(F.conv_w + D + ch0 + 4);
            const f32x4 w2a = *(const f32x4*)(F.conv_w + 2 * D + ch0), w2b = *(const f32x4*)(F.conv_w + 2 * D + ch0 + 4);
            float w0[8] = {w0a.x, w0a.y, w0a.z, w0a.w, w0b.x, w0b.y, w0b.z, w0b.w}, w1[8] = {w1a.x, w1a.y, w1a.z, w1a.w, w1b.x, w1b.y, w1b.z, w1b.w}, w2[8] = {w2a.x, w2a.y, w2a.z, w2a.w, w2b.x, w2b.y, w2b.z, w2b.w};
            unsigned o[4];
#pragma unroll
            for (int e = 0; e < 4; ++e) {
                const float y0 = bf_lo(gg[e]) * (w0[2 * e] * bf_lo(pp[e]) + w1[2 * e] * bf_lo(pc[e]) + w2[2 * e] * bf_lo(pn[e]));
                const float y1 = bf_hi(gg[e]) * (w0[2 * e + 1] * bf_hi(pp[e]) + w1[2 * e + 1] * bf_hi(pc[e]) + w2[2 * e + 1] * bf_hi(pn[e]));
                o[e] = pk2(y0, y1); }
            *(GAS v4u*)(Y + off) = (v4u){o[0], o[1], o[2], o[3]}; }
    }
}
__device__ __forceinline__ void p5_mid(Frame& F) {
    const int gw = F.vcu * NWAVES + F.wave, NGW = F.G * NWAVES;
    const float* Y = (const float*)F.R1;
    for (int m = gw; m < M_ALL; m += NGW) {
        const GAS f32x4* yr = (const GAS f32x4*)(Y + (size_t)m * D) + F.lane; const GAS f32x4* xr = (const GAS f32x4*)in_row(F, m) + F.lane; f32x4 y[4], xv[4];
#pragma unroll
        for (int j = 0; j < 4; ++j) { y[j] = yr[64 * j]; xv[j] = xr[64 * j]; }
        const float rstd = __builtin_amdgcn_rsqf(wave_sum(sumsq4(y)) * (1.f / D) + EPS);
        const float* md0 = F.MOD + (size_t)mod_vec(m) * (3 * D);
#pragma unroll
        for (int j = 0; j < 4; ++j) { const int col = 4 * (F.lane + 64 * j);
            const f32x4 gt = *(const f32x4*)(md0 + 2 * D + col), gp = *(const f32x4*)(F.g_post + col);
            xv[j] = xv[j] + gt * ((y[j] * rstd) * gp); }
        if (m < M_LAT) { GAS f32x4* o = (GAS f32x4*)(F.X1 + (size_t)m * D) + F.lane;
#pragma unroll
            for (int j = 0; j < 4; ++j) o[64 * j] = xv[j]; }
        const float rstd1 = __builtin_amdgcn_rsqf(wave_sum(sumsq4(xv)) * (1.f / D) + EPS);
        mod_store_bf16(F, xv, rstd1, F.g_pre + D, F.MOD + (size_t)(9 + mod_vec(m)) * (3 * D), F.H + (size_t)m * D);
    }
}
__device__ __forceinline__ void p9_final(Frame& F) {
    const int gw = F.vcu * NWAVES + F.wave, NGW = F.G * NWAVES;
    const float* Y = (const float*)F.R1;
    for (int m = gw; m < M_LAT; m += NGW) {
        const GAS f32x4* yr = (const GAS f32x4*)(Y + (size_t)m * D) + F.lane; const GAS f32x4* xr = (const GAS f32x4*)(F.X1 + (size_t)m * D) + F.lane; f32x4 y[4], xv[4];
#pragma unroll
        for (int j = 0; j < 4; ++j) { y[j] = yr[64 * j]; xv[j] = xr[64 * j]; }
        const float rstd = __builtin_amdgcn_rsqf(wave_sum(sumsq4(y)) * (1.f / D) + EPS);
        const float* md1 = F.MOD + (size_t)(9 + (m >> 13)) * (3 * D);
        GAS f32x4* o = (GAS f32x4*)(F.out + (size_t)m * D) + F.lane;
#pragma unroll
        for (int j = 0; j < 4; ++j) { const int col = 4 * (F.lane + 64 * j);
            const f32x4 gt = *(const f32x4*)(md1 + 2 * D + col), gp = *(const f32x4*)(F.g_post + D + col);
            o[64 * j] = xv[j] + gt * ((y[j] * rstd) * gp); }
    }
}
__device__ __forceinline__ void p7_na_simple(Frame& F) {
    const int gw = F.vcu * NWAVES + F.wave, NGW = F.G * NWAVES;
    const bf16 *Qb = F.R1, *Kb = F.R2, *Vb = F.R3, *Zb = F.R4; bf16* Ob = F.H;
    for (int it = gw; it < NB * GROWS * NH; it += NGW) {
        const int h = it & 15, r = (it >> 4) & 127, b = it >> 11, c = F.lane;
        const size_t qoff = ((size_t)b * SEQ + r * GW + c) * D + h * HD;
        float q[64], o[64]; float mx = -INFINITY, l = 0.f;
        { const GAS v4u* qp = (const GAS v4u*)(Qb + qoff);
#pragma unroll
          for (int i = 0; i < 8; ++i) { const v4u w = qp[i];
#pragma unroll
              for (int e = 0; e < 4; ++e) { q[8 * i + 2 * e] = bf_lo(w[e]); q[8 * i + 2 * e + 1] = bf_hi(w[e]); } } }
#pragma unroll
        for (int d = 0; d < 64; ++d) o[d] = 0.f;
#define NA_KEY(KROW, BIAS) do { const size_t ko_ = (size_t)(KROW) * D + h * HD; const GAS v4u* kp_ = (const GAS v4u*)(Kb + ko_); const GAS v4u* vp_ = (const GAS v4u*)(Vb + ko_); \
        float s_ = (BIAS); \
        _Pragma("unroll") for (int i = 0; i < 8; ++i) { const v4u w = kp_[i]; \
            _Pragma("unroll") for (int e = 0; e < 4; ++e) { s_ += q[8 * i + 2 * e] * bf_lo(w[e]); s_ += q[8 * i + 2 * e + 1] * bf_hi(w[e]); } } \
        const float mn_ = fmaxf(mx, s_), f_ = __builtin_amdgcn_exp2f(mx - mn_), p_ = __builtin_amdgcn_exp2f(s_ - mn_); l = l * f_ + p_; mx = mn_; \
        _Pragma("unroll") for (int i = 0; i < 8; ++i) { const v4u w = vp_[i]; \
            _Pragma("unroll") for (int e = 0; e < 4; ++e) { o[8 * i + 2 * e] = o[8 * i + 2 * e] * f_ + p_ * bf_lo(w[e]); o[8 * i + 2 * e + 1] = o[8 * i + 2 * e + 1] * f_ + p_ * bf_hi(w[e]); } } } while (0)
        for (int j = 0; j < LC; ++j) NA_KEY(M_LAT + b * LC + j, 0.f);
        const int rs = min(max(r - 4, 0), GROWS - 8), cs = min(max(c - 8, 0), GW - 16);
        for (int i = 0; i < 8; ++i) { const float* brow = F.rpb + ((size_t)h * 15 + (rs + i - r + 7)) * 31 + (cs - c + 15);
            for (int jj = 0; jj < 16; ++jj) NA_KEY((size_t)b * SEQ + (rs + i) * GW + cs + jj, brow[jj] * LOG2E); }
#undef NA_KEY
        const float inv = 1.0f / l;
        const GAS v4u* zp = (const GAS v4u*)(Zb + qoff); GAS v4u* op = (GAS v4u*)(Ob + qoff);
#pragma unroll
        for (int i = 0; i < 8; ++i) { const v4u z = zp[i]; v4u w;
#pragma unroll
            for (int e = 0; e < 4; ++e) w[e] = pk2(o[8 * i + 2 * e] * inv * silu_f(bf_lo(z[e])), o[8 * i + 2 * e + 1] * inv * silu_f(bf_hi(z[e])));
            op[i] = w; }
    }
}

struct Args { const float* in[14]; float* out; unsigned char* ws; int ph_lo, ph_hi, li, pad; };
__global__ void __launch_bounds__(NWAVES * 64, 2) skel_fwd(Args args) {
    extern __shared__ __attribute__((aligned(16))) unsigned char lds[];
    Frame F;
    F.lds = (LAS unsigned char*)lds;
    F.MISC = (volatile LAS unsigned*)(F.lds + MISC_OFF);
    F.tid = threadIdx.x; F.lane = F.tid & 63; F.wave = __builtin_amdgcn_readfirstlane(F.tid >> 6);
    F.G = gridDim.x; { const int bx = blockIdx.x; F.vcu = (F.G % 8 == 0) ? (bx % 8) * (F.G / 8) + bx / 8 : bx; }
#define GRID_BAR(seam) do { if (N_LAUNCHES != 1) { if (F.tid == 0) __hip_atomic_store(F.ctl + CW_TMO, 0xBADBA0u | (unsigned)(seam), RLX_AGENT); } \
    else { xcd_barrier(bar); } } while (0)
    unsigned char* ws = args.ws;
    F.ctl = (gu32*)(ws + WS_CTL);
    F.x = args.in[0]; F.c = args.in[1]; F.ctx = args.in[2]; F.c_ctx = args.in[3]; F.g_pre = args.in[4]; F.g_post = args.in[5]; F.w_mod = args.in[6]; F.b_mod = args.in[7];
    F.w_in_conv = args.in[8]; F.conv_w = args.in[9]; F.w_out_conv = args.in[10]; F.w_in_na = args.in[11]; F.rpb = args.in[12]; F.w_out_na = args.in[13]; F.out = args.out;
    F.MOD = (float*)(ws + WS_MOD); F.W1T = (bf16*)(ws + WS_W1T); F.W2T = (bf16*)(ws + WS_W2T); F.W3T = (bf16*)(ws + WS_W3T); F.W4T = (bf16*)(ws + WS_W4T);
    F.H = (bf16*)(ws + WS_H); F.R1 = (bf16*)(ws + WS_R1); F.R2 = (bf16*)(ws + WS_R2); F.R3 = (bf16*)(ws + WS_R3); F.R4 = (bf16*)(ws + WS_R4); F.X1 = (float*)(ws + WS_X1);
    for (int u = F.tid; u < (LDS_BYTES - LDSCTL_OFF) / 4; u += NWAVES * 64) ((LAS unsigned*)(F.lds + LDSCTL_OFF))[u] = 0u;
    __syncthreads();
    XcdBarrier bar; bar.bar = (unsigned*)(F.ctl + CW_BAR); bar.x = 0; bar.st = nullptr;
    if (N_LAUNCHES == 1) bar = xcd_barrier_post((unsigned*)(F.ctl + CW_BAR), F.MISC + 8);

    const int lo = args.ph_lo, hi = args.ph_hi;
#define IN(k) (lo <= (k) && (k) < hi)
#define BOTH(k) (IN(k) && IN((k) + 1))
    if (IN(0)) { p0_prologue(F); if (BOTH(0)) GRID_BAR(0); }
    if (IN(1)) { p1_h0(F); if (BOTH(1)) GRID_BAR(1); }
    if (IN(2)) {
        pg8::Gemm g{F.H, F.W1T, M_ALL, N4, D}; pg8::StaticOrder S; S.init(M_ALL, N4, F.G, (int)blockIdx.x);
        pg8::EpiGate E{F.R1, F.R2};
        pg8::gemm_phase<pg8::EpiGate, pg8::StaticOrder, PG8_ALIGN, PG8_SP2>(F.lds + RING_OFF, g, S, E);
        if (BOTH(2)) GRID_BAR(2);
    }
    if (IN(3)) { p3_conv(F); if (BOTH(3)) GRID_BAR(3); }
    if (IN(4)) {
        pg8::Gemm g{F.R3, F.W2T, M_ALL, D, D}; pg8::StaticOrder S; S.init(M_ALL, D, F.G, (int)blockIdx.x);
        pg8::EpiF32 E{(float*)F.R1, D};
        pg8::gemm_phase<pg8::EpiF32, pg8::StaticOrder, PG8_ALIGN, PG8_SP2>(F.lds + RING_OFF, g, S, E);
        if (BOTH(4)) GRID_BAR(4);
    }
    if (IN(5)) { p5_mid(F); if (BOTH(5)) GRID_BAR(5); }
    if (IN(6)) {
        pg8::Gemm g{F.H, F.W3T, M_ALL, N4, D}; pg8::StaticOrder S; S.init(M_ALL, N4, F.G, (int)blockIdx.x);
        pg8::EpiBf16Split E{F.R1, D, D, RSZ / 2, QSCALE};
        pg8::gemm_phase<pg8::EpiBf16Split, pg8::StaticOrder, PG8_ALIGN, PG8_SP2>(F.lds + RING_OFF, g, S, E);
        if (BOTH(6)) GRID_BAR(6);
    }
    if (IN(7)) { p7_na_simple(F); if (BOTH(7)) GRID_BAR(7); }
    if (IN(8)) {
        pg8::Gemm g{F.H, F.W4T, M_LAT, D, D}; pg8::StaticOrder S; S.init(M_LAT, D, F.G, (int)blockIdx.x);
        pg8::EpiF32 E{(float*)F.R1, D};
        pg8::gemm_phase<pg8::EpiF32, pg8::StaticOrder, PG8_ALIGN, PG8_SP2>(F.lds + RING_OFF, g, S, E);
        if (BOTH(8)) GRID_BAR(8);
    }
    if (IN(9)) { p9_final(F); }
#undef IN
#undef BOTH
}

extern "C" void kernel_launch(void* const* d_in, const int* in_sizes, int n_in, void* d_out, int out_size, void* d_ws, size_t ws_size, hipStream_t stream) {
    static int grid = 0;
    if (grid == 0) {
        if (n_in != 14 || in_sizes[0] != M_LAT * D || out_size != M_LAT * D || ws_size < WS_END) { fprintf(stderr, "kernel_launch: unexpected shapes (n_in %d, in0 %d, out %d, ws %zu < %zu); nothing launched\n", n_in, n_in > 0 ? in_sizes[0] : -1, out_size, ws_size, (size_t)WS_END); grid = -1; return; }
        int dev = 0, cus = 0, per_cu = 0;
        if (hipGetDevice(&dev) != hipSuccess || hipDeviceGetAttribute(&cus, hipDeviceAttributeMultiprocessorCount, dev) != hipSuccess) { grid = -1; return; }
        if (hipFuncSetAttribute((const void*)skel_fwd, hipFuncAttributeMaxDynamicSharedMemorySize, LDS_BYTES) != hipSuccess) { fprintf(stderr, "kernel_launch: hipFuncSetAttribute failed\n"); grid = -1; return; }
        if (hipOccupancyMaxActiveBlocksPerMultiprocessor(&per_cu, (const void*)skel_fwd, NWAVES * 64, LDS_BYTES) != hipSuccess || per_cu < 1)
            fprintf(stderr, "kernel_launch: note: occupancy query reports %d workgroups per CU\n", per_cu);
        (void)hipGetLastError();
        grid = cus;
    }
    if (grid < 0) return;
    if (hipMemsetAsync((char*)d_ws + WS_CTL, 0, CTL_ZERO_BYTES, stream) != hipSuccess) return;
    Args a{};
    for (int i = 0; i < 14; ++i) a.in[i] = (const float*)d_in[i];
    a.out = (float*)d_out; a.ws = (unsigned char*)d_ws;
    for (int li = 0; li < N_LAUNCHES; ++li) {
        a.ph_lo = (N_LAUNCHES == 1) ? 0 : li; a.ph_hi = (N_LAUNCHES == 1) ? N_PHASES : li + 1; a.li = li;
        hipLaunchKernelGGL(skel_fwd, dim3(grid), dim3(NWAVES * 64), LDS_BYTES, stream, a);
        if (hipPeekAtLastError() != hipSuccess) break;
    }
}
```

```cpp
#include <hip/hip_runtime.h>
#include <cstdio>
#include <cstdint>
namespace pg8 {
#define PG8_LAS __attribute__((address_space(3)))
typedef unsigned short bf16_t;
typedef short bf16x8 __attribute__((ext_vector_type(8)));
typedef float f32x4 __attribute__((ext_vector_type(4)));
typedef unsigned u32x4 __attribute__((ext_vector_type(4)));
constexpr int BM = 256, BK = 64, HALF = 128, HTB = HALF * BK * 2  , STAGE_BYTES = 8 * HTB, NXCD = 8, WGM = 8;

__host__ __device__ __forceinline__ int lds_byte(int r, int c) { const int st = (r >> 4) * 2 + (c >> 5), rr = r & 15, cc = c & 31, ob = rr * 64 + cc * 2; return st * 1024 + (ob ^ (((ob >> 9) & 1) << 5)); }
__host__ __device__ __forceinline__ void stage_rc(int b, int& R, int& C) { const int st = b / 1024, sb = b % 1024, swz = sb ^ (((sb >> 9) & 1) << 5); R = (st >> 1) * 16 + swz / 64; C = (st & 1) * 32 + (swz % 64) / 2; }
__host__ __device__ __forceinline__ int perm32(int rho) { const int n = rho >> 4, i = rho & 15; return 8 * (i >> 2) + 4 * n + (i & 3); }

struct Unit { int pm, pn; };
struct Gemm { const bf16_t* A; const bf16_t* Bt; int M, N, K; };

struct StaticOrder {
    int nM, nN, nwg, G, c;
    __host__ __device__ void init(int M, int N, int G_, int c_) { nM = M / BM; nN = N / BM; nwg = nM * nN; G = G_; c = c_; }
    __host__ __device__ bool next(int i, Unit& u) const {
        const long L = (long)i * G + c; if (L >= nwg) return false;
        int wgid = (int)L; { const int q = nwg / NXCD, r = nwg % NXCD, xcd = wgid % NXCD, off = wgid / NXCD; wgid = (xcd < r ? xcd * (q + 1) : r * (q + 1) + (xcd - r) * q) + off; }
        const int nig = WGM * nN, gid = wgid / nig, fm = gid * WGM, gsz = (nM - fm) < WGM ? (nM - fm) : WGM;
        u.pm = fm + ((wgid % nig) % gsz); u.pn = (wgid % nig) / gsz; return true;
    }
    __device__ __forceinline__ void a_ready(const Unit&) const {}
    __device__ __forceinline__ void done(const Unit&) const {}
};

__device__ __forceinline__ unsigned cvt_pk_bf16(float lo, float hi) { unsigned r; asm volatile("v_cvt_pk_bf16_f32 %0, %1, %2" : "=v"(r) : "v"(lo), "v"(hi)); return r; }
typedef unsigned u32x2 __attribute__((ext_vector_type(2)));
__device__ __forceinline__ float silu_f(float z) { return z * __builtin_amdgcn_rcpf(1.0f + __expf(-z)); }

struct EpiBf16Split {
    static constexpr bool PERM = true, AFTER_DRAIN = false;
    bf16_t* O; int ldc; int split_cols; size_t split_stride; float scale0;
    __device__ __forceinline__ void operator()(const f32x4 (&acc)[2][2][4][2], const Unit& u, int wr, int wc, int fr, int fq) const {
        const int row0 = u.pm * BM + wr * 64 + fr; int colt = u.pn * BM; bf16_t* base = O;
        float sc = 1.f; { const int t = colt / split_cols; base += (size_t)t * split_stride; colt -= t * split_cols; if (t == 0) sc = scale0; }
        const int col0 = colt + wc * 32 + 8 * fq;
#pragma unroll
        for (int ai = 0; ai < 2; ++ai)
#pragma unroll
            for (int m = 0; m < 4; ++m) { bf16_t* rowp = base + (size_t)(row0 + ai * HALF + m * 16) * ldc + col0;
#pragma unroll
                for (int bj = 0; bj < 2; ++bj) { const f32x4 v0 = acc[ai][bj][m][0] * sc, v1 = acc[ai][bj][m][1] * sc;
                    u32x4 w; w.x = cvt_pk_bf16(v0[0], v0[1]); w.y = cvt_pk_bf16(v0[2], v0[3]); w.z = cvt_pk_bf16(v1[0], v1[1]); w.w = cvt_pk_bf16(v1[2], v1[3]);
                    *(u32x4*)(rowp + bj * HALF) = w; } }
    }
};
struct EpiGate {
    static constexpr bool PERM = false, AFTER_DRAIN = false;
    bf16_t* P; bf16_t* G;
    __device__ __forceinline__ void operator()(const f32x4 (&acc)[2][2][4][2], const Unit& u, int wr, int wc, int fr, int fq) const {
        const int row0 = u.pm * BM + wr * 64 + fr, ch0 = u.pn * 64 + wc * 16 + 4 * fq;
#pragma unroll
        for (int ai = 0; ai < 2; ++ai)
#pragma unroll
            for (int m = 0; m < 4; ++m) { const size_t off = (size_t)(row0 + ai * HALF + m * 16) * 1024 + ch0;
                const f32x4 bg = acc[ai][0][m][0], cg = acc[ai][0][m][1], uu = acc[ai][1][m][0], zz = acc[ai][1][m][1];
                const f32x4 p = cg * uu; f32x4 g;
#pragma unroll
                for (int j = 0; j < 4; ++j) g[j] = bg[j] * silu_f(zz[j]);
                u32x2 wp, wg; wp.x = cvt_pk_bf16(p[0], p[1]); wp.y = cvt_pk_bf16(p[2], p[3]); wg.x = cvt_pk_bf16(g[0], g[1]); wg.y = cvt_pk_bf16(g[2], g[3]);
                *(u32x2*)(P + off) = wp; *(u32x2*)(G + off) = wg; }
    }
};
struct EpiF32 {
    static constexpr bool PERM = false, AFTER_DRAIN = false;
    float* O; int ldc;
    __device__ __forceinline__ void operator()(const f32x4 (&acc)[2][2][4][2], const Unit& u, int wr, int wc, int fr, int fq) const {
        const int row0 = u.pm * BM + wr * 64 + fr, col0 = u.pn * BM + wc * 32 + 4 * fq;
#pragma unroll
        for (int ai = 0; ai < 2; ++ai)
#pragma unroll
            for (int m = 0; m < 4; ++m) { float* rowp = O + (size_t)(row0 + ai * HALF + m * 16) * ldc + col0;
#pragma unroll
                for (int bj = 0; bj < 2; ++bj)
#pragma unroll
                    for (int n = 0; n < 2; ++n) *(f32x4*)(rowp + bj * HALF + n * 16) = acc[ai][bj][m][n]; }
    }
};
template <class Epi, class Sched, bool ALIGN_EPI = false, bool SP2 = false>
__device__ __forceinline__ void gemm_phase(PG8_LAS unsigned char* lds, const Gemm g, const Sched& S, const Epi& E) {
    const int tid = threadIdx.x, wid = __builtin_amdgcn_readfirstlane(tid >> 6), lane = tid & 63, wr = wid >> 2, wc = wid & 3, fr = lane & 15, fq = lane >> 4;
    const int K = g.K, nt = K / BK;
    unsigned voffA[2], voffB[2];
#pragma unroll
    for (int i = 0; i < 2; ++i) { int R, C; stage_rc(tid * 16 + i * 8192, R, C); const int Rb = Epi::PERM ? ((R & ~31) + perm32(R & 31)) : R;
        voffA[i] = (unsigned)(R * K + C) * 2u; voffB[i] = (unsigned)(Rb * K + C) * 2u; }
    const size_t kstep = (size_t)(BK * 2);
    const size_t hstep = (size_t)HALF * K * 2;
    const size_t tstep = 2 * hstep;
    const unsigned ldsw = (unsigned)wid * 1024u;
    const int aoff = lds_byte(wr * 64 + fr, fq * 8), boff = lds_byte(wc * 32 + fr, fq * 8);
#define PG8_SA(b, h) (((b) * 2 + (h)) * HTB)
#define PG8_SB(b, h) ((4 + (b) * 2 + (h)) * HTB)
#define PG8_STAGE(bufoff, gbase, voff) do { _Pragma("unroll") for (int _i = 0; _i < 2; ++_i) \
        __builtin_amdgcn_global_load_lds((const unsigned*)((const char*)(gbase) + (voff)[_i]), (PG8_LAS unsigned*)(lds + (bufoff) + ldsw + _i * 8192), 16, 0, 0); } while (0)
#define PG8_LDA(dst, b, h) do { _Pragma("unroll") for (int m = 0; m < 4; ++m) _Pragma("unroll") for (int k = 0; k < 2; ++k) dst[m][k] = *(const PG8_LAS bf16x8*)(lds + PG8_SA(b, h) + aoff + m * 2048 + k * 1024); } while (0)
#define PG8_LDB(dst, b, h) do { _Pragma("unroll") for (int n = 0; n < 2; ++n) _Pragma("unroll") for (int k = 0; k < 2; ++k) dst[n][k] = *(const PG8_LAS bf16x8*)(lds + PG8_SB(b, h) + boff + n * 2048 + k * 1024); } while (0)
#define PG8_MMA(ai, bj, At, Bt) do { __builtin_amdgcn_s_setprio(1); _Pragma("unroll") for (int m = 0; m < 4; ++m) _Pragma("unroll") for (int n = 0; n < 2; ++n) _Pragma("unroll") for (int k = 0; k < 2; ++k) \
        acc[ai][bj][m][n] = __builtin_amdgcn_mfma_f32_16x16x32_bf16(Bt[n][k], At[m][k], acc[ai][bj][m][n], 0, 0, 0); __builtin_amdgcn_s_setprio(0); } while (0)
#define PG8_WAIT_V(n) asm volatile("s_waitcnt vmcnt(" #n ")" ::: "memory")
#define PG8_WAIT_L(n) asm volatile("s_waitcnt lgkmcnt(" #n ")" ::: "memory")
#define PG8_BAR __builtin_amdgcn_s_barrier()
#define PG8_SCHED __builtin_amdgcn_sched_barrier(0)
    Unit cur, nxt; int ui = 0;
    if (!S.next(0, cur)) return;
    f32x4 acc[2][2][4][2];
#pragma unroll
    for (int a = 0; a < 2; ++a)
#pragma unroll
        for (int b = 0; b < 2; ++b)
#pragma unroll
            for (int m = 0; m < 4; ++m)
#pragma unroll
                for (int n = 0; n < 2; ++n) acc[a][b][m][n] = (f32x4){0.f, 0.f, 0.f, 0.f};
    bf16x8 At[4][2], B0[2][2], B1[2][2];
    const char* cA = (const char*)g.A + (size_t)cur.pm * tstep; const char* cB = (const char*)g.Bt + (size_t)cur.pn * tstep;
    S.a_ready(cur);
    if constexpr (SP2) {
        PG8_STAGE(PG8_SB(0, 0), cB, voffB); PG8_STAGE(PG8_SB(0, 1), cB + hstep, voffB); PG8_STAGE(PG8_SA(0, 0), cA, voffA); PG8_STAGE(PG8_SA(0, 1), cA + hstep, voffA);
        if (wr == 1) PG8_BAR;
        PG8_WAIT_V(2); PG8_BAR;
        PG8_STAGE(PG8_SB(1, 0), cB + kstep, voffB); PG8_STAGE(PG8_SA(1, 0), cA + kstep, voffA); PG8_STAGE(PG8_SB(1, 1), cB + hstep + kstep, voffB);
        PG8_WAIT_V(6); PG8_BAR;
    } else {
        PG8_STAGE(PG8_SB(0, 0), cB, voffB); PG8_STAGE(PG8_SA(0, 0), cA, voffA); PG8_STAGE(PG8_SB(0, 1), cB + hstep, voffB); PG8_STAGE(PG8_SA(0, 1), cA + hstep, voffA);
        if (wr == 1) PG8_BAR;
        PG8_WAIT_V(4); PG8_BAR;
        PG8_STAGE(PG8_SB(1, 0), cB + kstep, voffB); PG8_STAGE(PG8_SA(1, 0), cA + kstep, voffA); PG8_STAGE(PG8_SB(1, 1), cB + hstep + kstep, voffB);
        PG8_WAIT_V(6); PG8_BAR;
    }
    for (;;) {
        const bool has_next = S.next(ui + 1, nxt);
        const char* nA = has_next ? (const char*)g.A + (size_t)nxt.pm * tstep : cA; const char* nB = has_next ? (const char*)g.Bt + (size_t)nxt.pn * tstep : cB;
        for (int t = 0; t < nt; t += 2) {
            const bool last = (t == nt - 2);
            const char* a1 = cA + (size_t)(t + 1) * kstep;
            const char* a2 = last ? nA : cA + (size_t)(t + 2) * kstep; const char* b2 = last ? nB : cB + (size_t)(t + 2) * kstep;
            const char* a3 = a2 + kstep; const char* b3 = b2 + kstep;
            if (last && has_next) S.a_ready(nxt);
            if constexpr (SP2) {
            PG8_LDB(B0, 0, 0); PG8_LDB(B1, 0, 1); PG8_SCHED; PG8_LDA(At, 0, 0); PG8_STAGE(PG8_SA(1, 1), a1 + hstep, voffA);
            PG8_WAIT_V(8); PG8_WAIT_L(0); PG8_BAR; PG8_MMA(0, 0, At, B0); PG8_MMA(0, 1, At, B1); PG8_BAR; PG8_SCHED;
            PG8_LDA(At, 0, 1); PG8_STAGE(PG8_SB(0, 0), b2, voffB); PG8_STAGE(PG8_SB(0, 1), b2 + hstep, voffB); PG8_STAGE(PG8_SA(0, 0), a2, voffA);
            PG8_WAIT_V(8); PG8_WAIT_L(0); PG8_BAR; PG8_MMA(1, 0, At, B0); PG8_MMA(1, 1, At, B1); PG8_BAR; PG8_SCHED;
            PG8_LDB(B0, 1, 0); PG8_LDB(B1, 1, 1); PG8_SCHED; PG8_LDA(At, 1, 0); PG8_STAGE(PG8_SA(0, 1), a2 + hstep, voffA);
            PG8_WAIT_V(8); PG8_WAIT_L(0); PG8_BAR; PG8_MMA(0, 0, At, B0); PG8_MMA(0, 1, At, B1); PG8_BAR; PG8_SCHED;
            PG8_LDA(At, 1, 1); PG8_STAGE(PG8_SB(1, 0), b3, voffB); PG8_STAGE(PG8_SB(1, 1), b3 + hstep, voffB); PG8_STAGE(PG8_SA(1, 0), a3, voffA);
            PG8_WAIT_V(8); PG8_WAIT_L(0); PG8_BAR; PG8_MMA(1, 0, At, B0); PG8_MMA(1, 1, At, B1); PG8_BAR; PG8_SCHED;
            } else {
            PG8_LDB(B0, 0, 0); PG8_SCHED; PG8_LDA(At, 0, 0); PG8_STAGE(PG8_SA(1, 1), a1 + hstep, voffA);
            PG8_WAIT_L(8); PG8_BAR; PG8_WAIT_L(0); PG8_MMA(0, 0, At, B0); PG8_BAR; PG8_SCHED;
            PG8_LDB(B1, 0, 1); PG8_STAGE(PG8_SB(0, 0), b2, voffB);
            PG8_BAR; PG8_WAIT_L(0); PG8_MMA(0, 1, At, B1); PG8_BAR;
            PG8_LDA(At, 0, 1); PG8_STAGE(PG8_SA(0, 0), a2, voffA);
            PG8_BAR; PG8_WAIT_L(0); PG8_MMA(1, 0, At, B0); PG8_BAR; PG8_SCHED;
            PG8_STAGE(PG8_SB(0, 1), b2 + hstep, voffB);
            PG8_WAIT_V(6); PG8_BAR; PG8_MMA(1, 1, At, B1); PG8_BAR;
            PG8_LDB(B0, 1, 0); PG8_SCHED; PG8_LDA(At, 1, 0); PG8_STAGE(PG8_SA(0, 1), a2 + hstep, voffA);
            PG8_WAIT_L(8); PG8_BAR; PG8_WAIT_L(0); PG8_MMA(0, 0, At, B0); PG8_BAR; PG8_SCHED;
            PG8_LDB(B1, 1, 1); PG8_STAGE(PG8_SB(1, 0), b3, voffB);
            PG8_BAR; PG8_WAIT_L(0); PG8_MMA(0, 1, At, B1); PG8_BAR;
            PG8_LDA(At, 1, 1); PG8_STAGE(PG8_SA(1, 0), a3, voffA);
            PG8_BAR; PG8_WAIT_L(0); PG8_MMA(1, 0, At, B0); PG8_BAR; PG8_SCHED;
            PG8_STAGE(PG8_SB(1, 1), b3 + hstep, voffB);
            PG8_WAIT_V(6); PG8_BAR; PG8_MMA(1, 1, At, B1); PG8_BAR;
            }
        }
        if constexpr (ALIGN_EPI) { if (wr == 0) PG8_BAR; }
        if constexpr (!Epi::AFTER_DRAIN) { E(acc, cur, wr, wc, fr, fq); S.done(cur); }
        if (!has_next) break;
#pragma unroll
        for (int a = 0; a < 2; ++a)
#pragma unroll
            for (int b = 0; b < 2; ++b)
#pragma unroll
                for (int m = 0; m < 4; ++m)
#pragma unroll
                    for (int n = 0; n < 2; ++n) acc[a][b][m][n] = (f32x4){0.f, 0.f, 0.f, 0.f};
        cur = nxt; cA = nA; cB = nB; ++ui;
        if constexpr (ALIGN_EPI) { if (wr == 1) PG8_BAR; }
    }
    PG8_WAIT_V(0);
    if constexpr (!ALIGN_EPI) { if (wr == 0) PG8_BAR; }
    PG8_BAR;
    if constexpr (Epi::AFTER_DRAIN) { E.fused(acc, cur, wr, wc, fr, fq, lds, wid, lane); S.done(cur); }
#undef PG8_SA
#undef PG8_SB
#undef PG8_STAGE
#undef PG8_LDA
#undef PG8_LDB
#undef PG8_MMA
#undef PG8_WAIT_V
#undef PG8_WAIT_L
#undef PG8_BAR
#undef PG8_SCHED
}
}
#ifndef PG8_SP2
#define PG8_SP2 true
#endif
#ifndef PG8_ALIGN
#define PG8_ALIGN true
#endif
constexpr int NWAVES = 8;
#ifndef MK_N_LAUNCHES
#define MK_N_LAUNCHES 1
#endif
constexpr int N_PHASES = 10;
constexpr int N_LAUNCHES = MK_N_LAUNCHES;
static_assert(N_LAUNCHES == 1 || N_LAUNCHES == N_PHASES, "MK_N_LAUNCHES is 1 or N_PHASES");

constexpr int NB = 8, SEQ = 8192, D = 1024, LC = 256, NH = 16, HD = 64, GW = 64, GROWS = SEQ / GW;
constexpr int M_LAT = NB * SEQ, M_CTX = NB * LC, M_ALL = M_LAT + M_CTX;
constexpr int N4 = 4 * D;
constexpr float EPS = 1e-6f;
constexpr float LOG2E = 1.4426950408889634f;
constexpr float QSCALE = 0.125f * LOG2E;
static_assert(M_ALL % 256 == 0, "rows");

constexpr size_t MiB = 1u << 20;
constexpr size_t WS_CTL = 0, CTL_ZERO_BYTES = 1 * MiB;
constexpr size_t WS_MOD = 1 * MiB;
constexpr size_t WS_W1T = 2 * MiB, WS_W2T = 10 * MiB, WS_W3T = 12 * MiB, WS_W4T = 20 * MiB;
constexpr size_t WS_H = 32 * MiB;
constexpr size_t RSZ = (size_t)M_ALL * D * 2;
constexpr size_t WS_R1 = WS_H + RSZ, WS_R2 = WS_R1 + RSZ, WS_R3 = WS_R2 + RSZ, WS_R4 = WS_R3 + RSZ;
constexpr size_t WS_X1 = WS_R4 + RSZ;
constexpr size_t WS_END = WS_X1 + (size_t)M_LAT * D * 4;
static_assert(RSZ == 132 * MiB && WS_END == 948 * MiB, "d_ws map");
constexpr int CW_TMO = 0, CW_CODE = 1;
constexpr int CW_BAR = 4096;

constexpr int RING_OFF = 0, RING_BYTES = 131072;
constexpr int LDSCTL_OFF = RING_BYTES, MISC_OFF = LDSCTL_OFF + 320;
constexpr int LDS_BYTES = 147456;
static_assert(MISC_OFF + 128 <= LDS_BYTES, "LDS map");

#define GAS __attribute__((address_space(1)))
#define LAS __attribute__((address_space(3)))
typedef unsigned short bf16;
typedef unsigned v4u __attribute__((ext_vector_type(4)));
typedef float f32x4 __attribute__((ext_vector_type(4)));
typedef short bf16x8 __attribute__((ext_vector_type(8)));
typedef GAS unsigned gu32;
typedef GAS unsigned long long gu64;
#define RLX_AGENT __ATOMIC_RELAXED, __HIP_MEMORY_SCOPE_AGENT
#define LDS_WAIT() asm volatile("s_waitcnt lgkmcnt(0)" ::: "memory")
#define VM_WAIT() asm volatile("s_waitcnt vmcnt(0)" ::: "memory")
__device__ __forceinline__ unsigned long long rt() { return __builtin_amdgcn_s_memrealtime(); }
__device__ __forceinline__ unsigned f2bf(float f) { unsigned u = __builtin_bit_cast(unsigned, f); return (u + 0x7fffu + ((u >> 16) & 1u)) >> 16; }
__device__ __forceinline__ unsigned pk2(float lo, float hi) { return f2bf(lo) | (f2bf(hi) << 16); }

#define XB_TMO      128
#define XB_XCNT(j)  (256  + 64 * (j))
#define XB_XSUB(j)  (1280 + 64 * (j))
#define XB_XGEN(j)  (2304 + 64 * (j))
#define XB_TOP      3328
#define XB_TOPGEN   3392
#define XCD_BAR_WORDS 3456
#define XB_SPIN_CAP (1u << 18)

__device__ __forceinline__ unsigned xb_ld(unsigned* p)              { return __hip_atomic_load(p, __ATOMIC_RELAXED, __HIP_MEMORY_SCOPE_AGENT); }
__device__ __forceinline__ unsigned xb_add(unsigned* p, unsigned v) { return __hip_atomic_fetch_add(p, v, __ATOMIC_RELAXED, __HIP_MEMORY_SCOPE_AGENT); }
__device__ __forceinline__ unsigned xb_xcc_id() { return (unsigned)__builtin_amdgcn_s_getreg((3 << 11) | 20) & 0xFu; }
#define XB_SPIN(cond, bar) do { unsigned _sp = 0; while (cond) { __builtin_amdgcn_s_sleep(1); \
    if ((++_sp & 255u) == 0u) { if (xb_ld(&(bar)[XB_TMO])) break; if (_sp > XB_SPIN_CAP) { atomicAdd(&(bar)[XB_TMO], 1u); break; } } } } while (0)

struct XcdBarrier {
    unsigned* bar; unsigned x;
    volatile LAS unsigned* st;
};

__device__ __forceinline__ XcdBarrier xcd_barrier_post(unsigned* bar, volatile LAS unsigned* st) {
    XcdBarrier b; b.bar = bar; b.x = xb_xcc_id(); b.st = st;
    if (threadIdx.x == 0) (void)xb_add(&bar[XB_XCNT(b.x)], 1u);
    return b;
}
__device__ __forceinline__ void xcd_barrier_complete(unsigned* bar, unsigned x, unsigned& nloc, unsigned& nx) {
    const unsigned G = gridDim.x * gridDim.y * gridDim.z;
    unsigned sum, cnt, mine, sp = 0u;
    for (;;) {
        sum = 0u; cnt = 0u; mine = 0u;
#pragma unroll
        for (unsigned j = 0; j < 16; ++j) { const unsigned c = xb_ld(&bar[XB_XCNT(j)]); sum += c; cnt += (c > 0u) ? 1u : 0u; mine = (j == x) ? c : mine; }
        if (sum == G) break;
        __builtin_amdgcn_s_sleep(1);
        if ((++sp & 255u) == 0u) { if (xb_ld(&bar[XB_TMO])) break; if (sp > XB_SPIN_CAP) { atomicAdd(&bar[XB_TMO], 1u); break; } }
    }
    nloc = mine > 0u ? mine : 1u; nx = cnt > 0u ? cnt : 1u;
}

__device__ __forceinline__ void xcd_barrier(const XcdBarrier& b) {
    asm volatile("s_waitcnt vmcnt(0)" ::: "memory");
    __syncthreads();
    if (threadIdx.x == 0) {
        unsigned* bar = b.bar;
        __builtin_amdgcn_s_waitcnt(0);
        unsigned nloc = b.st[0], nx = b.st[1];
        if (nloc == 0u) { xcd_barrier_complete(bar, b.x, nloc, nx); b.st[0] = nloc; b.st[1] = nx; }
        const unsigned old = xb_add(&bar[XB_XSUB(b.x)], 1u);
        const unsigned gen = old / nloc;
        if (old + 1u == (gen + 1u) * nloc) {
            __builtin_amdgcn_fence(__ATOMIC_RELEASE, "agent");
            asm volatile("s_waitcnt vmcnt(0)" ::: "memory");
            const unsigned og = xb_add(&bar[XB_TOP], 1u);
            const unsigned tg = og / nx;
            if (og + 1u == (tg + 1u) * nx) xb_add(&bar[XB_TOPGEN], 1u);
            else XB_SPIN(xb_ld(&bar[XB_TOPGEN]) == tg, bar);
            __builtin_amdgcn_fence(__ATOMIC_ACQUIRE, "agent");
            xb_add(&bar[XB_XGEN(b.x)], 1u);
            asm volatile("s_waitcnt vmcnt(0)" ::: "memory");
        } else {
            XB_SPIN(xb_ld(&bar[XB_XGEN(b.x)]) == gen, bar);
            __builtin_amdgcn_fence(__ATOMIC_ACQUIRE, "agent");
            asm volatile("s_waitcnt vmcnt(0)" ::: "memory");
        }
    }
    __syncthreads();
}
struct Frame {
    LAS unsigned char* lds;
    volatile LAS unsigned* MISC;
    gu32* ctl;
    int tid, lane, wave;
    int vcu, G;
    const float *x, *c, *ctx, *c_ctx, *g_pre, *g_post, *w_mod, *b_mod, *w_in_conv, *conv_w, *w_out_conv, *w_in_na, *rpb, *w_out_na;
    float* out;
    float* MOD; bf16 *W1T, *W2T, *W3T, *W4T, *H, *R1, *R2, *R3, *R4; float* X1;
};
__device__ __forceinline__ float wave_sum(float v) {
#pragma unroll
    for (int o = 1; o < 64; o <<= 1) v += __shfl_xor(v, o);
    return v;
}
__device__ __forceinline__ float bf_lo(unsigned w) { return __uint_as_float(w << 16); }
__device__ __forceinline__ float bf_hi(unsigned w) { return __uint_as_float(w & 0xffff0000u); }
__device__ __forceinline__ float silu_f(float z) { return z * __builtin_amdgcn_rcpf(1.0f + __expf(-z)); }

template <int MODE> __device__ __forceinline__ int w_dest_row(int n) {
    if (MODE == 0) return n;
    const int s = n >> 10, ch = n & 1023, pn = ch >> 6, t = ch & 63;
    return 256 * pn + 128 * (s >> 1) + 32 * (t >> 4) + 16 * (s & 1) + 4 * ((t >> 2) & 3) + (t & 3);
}
template <int MODE> __device__ __forceinline__ void p0_transpose_item(const float* W, int K, int N, bf16* WT, LAS float* scr, int item, int lane) {
    const int nblk = N / 32, kb = item / nblk, nb = item % nblk, k0 = 64 * kb, n0 = 32 * nb;
#pragma unroll 8
    for (int i = 0; i < 32; ++i) { const int kk = 2 * i + (lane >> 5); scr[kk * 33 + (lane & 31)] = W[(size_t)(k0 + kk) * N + n0 + (lane & 31)]; }
    LDS_WAIT(); asm volatile("" ::: "memory");
    const int c = lane & 7;
#pragma unroll
    for (int j = 0; j < 4; ++j) { const int n = (lane >> 3) + 8 * j; const LAS float* s = scr + (8 * c) * 33 + n;
        v4u o; o.x = pk2(s[0 * 33], s[1 * 33]); o.y = pk2(s[2 * 33], s[3 * 33]); o.z = pk2(s[4 * 33], s[5 * 33]); o.w = pk2(s[6 * 33], s[7 * 33]);
        *(GAS v4u*)(WT + (size_t)w_dest_row<MODE>(n0 + n) * K + k0 + 8 * c) = o; }
    LDS_WAIT(); asm volatile("" ::: "memory");
}
__device__ __forceinline__ void p0_prologue(Frame& F) {
    constexpr int MOD_ITEMS = 2 * (3 * D / 64);
    if ((int)blockIdx.x < MOD_ITEMS) {
        LAS float* stab = (LAS float*)(F.lds + RING_OFF);
        LAS float* red = (LAS float*)(F.lds + RING_OFF + 9 * D * 4);
        for (int o = F.tid; o < 9 * D; o += NWAVES * 64) { const int v = o >> 10, k = o & 1023; const float cv = (v < 8) ? F.c[v * D + k] : F.c_ctx[k]; stab[o] = silu_f(cv); }
        __syncthreads();
        for (int it = blockIdx.x; it < MOD_ITEMS; it += F.G) {
            const int i = it / 48, n0 = (it % 48) * 64;
            const float* W = F.w_mod + (size_t)i * D * 3 * D + n0 + F.lane;
            float acc[9];
#pragma unroll
            for (int v = 0; v < 9; ++v) acc[v] = 0.f;
            const int k0 = F.wave * 128;
#pragma unroll 16
            for (int k = k0; k < k0 + 128; ++k) { const float w = W[(size_t)k * (3 * D)];
#pragma unroll
                for (int v = 0; v < 9; ++v) acc[v] += stab[v * D + k] * w; }
#pragma unroll
            for (int v = 0; v < 9; ++v) red[(F.wave * 9 + v) * 64 + F.lane] = acc[v];
            __syncthreads();
            for (int o = F.tid; o < 9 * 64; o += NWAVES * 64) { const int v = o >> 6, l = o & 63; float s = 0.f;
#pragma unroll
                for (int w = 0; w < NWAVES; ++w) s += red[(w * 9 + v) * 64 + l];
                F.MOD[(size_t)(i * 9 + v) * (3 * D) + n0 + l] = s + F.b_mod[i * 3 * D + n0 + l]; }
            __syncthreads();
        }
    }
    LAS float* scr = (LAS float*)(F.lds + RING_OFF + F.wave * 16384);
    const int gw = F.vcu * NWAVES + F.wave, NGW = F.G * NWAVES;
    constexpr int I_IN = (D / 64) * (N4 / 32), I_OUT = (D / 64) * (D / 32);
    constexpr int NITEMS = 2 * I_IN + 2 * I_OUT;
    for (int it = gw; it < NITEMS; it += NGW) {
        int r = it;
        if (r < I_IN) { p0_transpose_item<1>(F.w_in_conv, D, N4, F.W1T, scr, r, F.lane); continue; } r -= I_IN;
        if (r < I_IN) { p0_transpose_item<0>(F.w_in_na, D, N4, F.W3T, scr, r, F.lane); continue; } r -= I_IN;
        if (r < I_OUT) { p0_transpose_item<0>(F.w_out_conv, D, D, F.W2T, scr, r, F.lane); continue; } r -= I_OUT;
        p0_transpose_item<0>(F.w_out_na, D, D, F.W4T, scr, r, F.lane);
    }
}
__device__ __forceinline__ const float* in_row(const Frame& F, int m) { return (m < M_LAT) ? F.x + (size_t)m * D : F.ctx + (size_t)(m - M_LAT) * D; }
__device__ __forceinline__ int mod_vec(int m) { return (m < M_LAT) ? (m >> 13) : 8; }
__device__ __forceinline__ void mod_store_bf16(const Frame& F, const f32x4 (&v)[4], float rstd, const float* gpre, const float* md, bf16* orow) {
    GAS unsigned long long* o8 = (GAS unsigned long long*)orow + F.lane;
#pragma unroll
    for (int j = 0; j < 4; ++j) { const int col = 4 * (F.lane + 64 * j);
        const f32x4 g = *(const f32x4*)(gpre + col), sh = *(const f32x4*)(md + col), sc = *(const f32x4*)(md + D + col);
        const f32x4 hv = (v[j] * rstd) * g * (sc + 1.0f) + sh;
        o8[64 * j] = (unsigned long long)pk2(hv.x, hv.y) | ((unsigned long long)pk2(hv.z, hv.w) << 32); }
}
__device__ __forceinline__ float sumsq4(const f32x4 (&v)[4]) { float s = 0.f;
#pragma unroll
    for (int j = 0; j < 4; ++j) s += (v[j].x * v[j].x + v[j].y * v[j].y) + (v[j].z * v[j].z + v[j].w * v[j].w);
    return s; }
__device__ __forceinline__ void p1_h0(Frame& F) {
    const int gw = F.vcu * NWAVES + F.wave, NGW = F.G * NWAVES;
    for (int m = gw; m < M_ALL; m += NGW) {
        const GAS f32x4* xr = (const GAS f32x4*)in_row(F, m) + F.lane; f32x4 v[4];
#pragma unroll
        for (int j = 0; j < 4; ++j) v[j] = xr[64 * j];
        const float rstd = __builtin_amdgcn_rsqf(wave_sum(sumsq4(v)) * (1.f / D) + EPS);
        mod_store_bf16(F, v, rstd, F.g_pre, F.MOD + (size_t)mod_vec(m) * (3 * D), F.H + (size_t)m * D);
    }
}
__device__ __forceinline__ void p3_conv(Frame& F) {
    const int gw = F.vcu * NWAVES + F.wave, NGW = F.G * NWAVES;
    const bf16 *P = F.R1, *Gt = F.R2; bf16* Y = F.R3;
    for (int m = gw; m < M_ALL; m += NGW) {
        const bool lat = m < M_LAT; const int pos = lat ? (m & (SEQ - 1)) : ((m - M_LAT) & (LC - 1)); const int len = lat ? SEQ : LC;
        const bool hasp = pos > 0, hasn = pos < len - 1;
#pragma unroll
        for (int j = 0; j < 2; ++j) { const int ch0 = 8 * (F.lane + 64 * j); const size_t off = (size_t)m * D + ch0;
            const v4u z4 = (v4u){0u, 0u, 0u, 0u};
            const v4u pc = *(const GAS v4u*)(P + off), gg = *(const GAS v4u*)(Gt + off);
            const v4u pp = hasp ? *(const GAS v4u*)(P + off - D) : z4, pn = hasn ? *(const GAS v4u*)(P + off + D) : z4;
            const f32x4 w0a = *(const f32x4*)(F.conv_w + ch0), w0b = *(const f32x4*)(F.conv_w + ch0 + 4);
            const f32x4 w1a = *(const f32x4*)(F.conv_w + D + ch0), w1b = *(const f32x4*)(F.conv_w + D + ch0 + 4);
            const f32x4 w2a = *(const f32x4*)(F.conv_w + 2 * D + ch0), w2b = *(const f32x4*)(F.conv_w + 2 * D + ch0 + 4);
            float w0[8] = {w0a.x, w0a.y, w0a.z, w0a.w, w0b.x, w0b.y, w0b.z, w0b.w}, w1[8] = {w1a.x, w1a.y, w1a.z, w1a.w, w1b.x, w1b.y, w1b.z, w1b.w}, w2[8] = {w2a.x, w2a.y, w2a.z, w2a.w, w2b.x, w2b.y, w2b.z, w2b.w};
            unsigned o[4];
#pragma unroll
            for (int e = 0; e < 4; ++e) {
                const float y0 = bf_lo(gg[e]) * (w0[2 * e] * bf_lo(pp[e]) + w1[2 * e] * bf_lo(pc[e]) + w2[2 * e] * bf_lo(pn[e]));
                const float y1 = bf_hi(gg[e]) * (w0[2 * e + 1] * bf_hi(pp[e]) + w1[2 * e + 1] * bf_hi(pc[e]) + w2[2 * e + 1] * bf_hi(pn[e]));
                o[e] = pk2(y0, y1); }
            *(GAS v4u*)(Y + off) = (v4u){o[0], o[1], o[2], o[3]}; }
    }
}
__device__ __forceinline__ void p5_mid(Frame& F) {
    const int gw = F.vcu * NWAVES + F.wave, NGW = F.G * NWAVES;
    const float* Y = (const float*)F.R1;
    for (int m = gw; m < M_ALL; m += NGW) {
        const GAS f32x4* yr = (const GAS f32x4*)(Y + (size_t)m * D) + F.lane; const GAS f32x4* xr = (const GAS f32x4*)in_row(F, m) + F.lane; f32x4 y[4], xv[4];
#pragma unroll
        for (int j = 0; j < 4; ++j) { y[j] = yr[64 * j]; xv[j] = xr[64 * j]; }
        const float rstd = __builtin_amdgcn_rsqf(wave_sum(sumsq4(y)) * (1.f / D) + EPS);
        const float* md0 = F.MOD + (size_t)mod_vec(m) * (3 * D);
#pragma unroll
        for (int j = 0; j < 4; ++j) { const int col = 4 * (F.lane + 64 * j);
            const f32x4 gt = *(const f32x4*)(md0 + 2 * D + col), gp = *(const f32x4*)(F.g_post + col);
            xv[j] = xv[j] + gt * ((y[j] * rstd) * gp); }
        if (m < M_LAT) { GAS f32x4* o = (GAS f32x4*)(F.X1 + (size_t)m * D) + F.lane;
#pragma unroll
            for (int j = 0; j < 4; ++j) o[64 * j] = xv[j]; }
        const float rstd1 = __builtin_amdgcn_rsqf(wave_sum(sumsq4(xv)) * (1.f / D) + EPS);
        mod_store_bf16(F, xv, rstd1, F.g_pre + D, F.MOD + (size_t)(9 + mod_vec(m)) * (3 * D), F.H + (size_t)m * D);
    }
}
__device__ __forceinline__ void p9_final(Frame& F) {
    const int gw = F.vcu * NWAVES + F.wave, NGW = F.G * NWAVES;
    const float* Y = (const float*)F.R1;
    for (int m = gw; m < M_LAT; m += NGW) {
        const GAS f32x4* yr = (const GAS f32x4*)(Y + (size_t)m * D) + F.lane; const GAS f32x4* xr = (const GAS f32x4*)(F.X1 + (size_t)m * D) + F.lane; f32x4 y[4], xv[4];
#pragma unroll
        for (int j = 0; j < 4; ++j) { y[j] = yr[64 * j]; xv[j] = xr[64 * j]; }
        const float rstd = __builtin_amdgcn_rsqf(wave_sum(sumsq4(y)) * (1.f / D) + EPS);
        const float* md1 = F.MOD + (size_t)(9 + (m >> 13)) * (3 * D);
        GAS f32x4* o = (GAS f32x4*)(F.out + (size_t)m * D) + F.lane;
#pragma unroll
        for (int j = 0; j < 4; ++j) { const int col = 4 * (F.lane + 64 * j);
            const f32x4 gt = *(const f32x4*)(md1 + 2 * D + col), gp = *(const f32x4*)(F.g_post + D + col);
            o[64 * j] = xv[j] + gt * ((y[j] * rstd) * gp); }
    }
}
__device__ __forceinline__ void p7_na_simple(Frame& F) {
    const int gw = F.vcu * NWAVES + F.wave, NGW = F.G * NWAVES;
    const bf16 *Qb = F.R1, *Kb = F.R2, *Vb = F.R3, *Zb = F.R4; bf16* Ob = F.H;
    for (int it = gw; it < NB * GROWS * NH; it += NGW) {
        const int h = it & 15, r = (it >> 4) & 127, b = it >> 11, c = F.lane;
        const size_t qoff = ((size_t)b * SEQ + r * GW + c) * D + h * HD;
        float q[64], o[64]; float mx = -INFINITY, l = 0.f;
        { const GAS v4u* qp = (const GAS v4u*)(Qb + qoff);
#pragma unroll
          for (int i = 0; i < 8; ++i) { const v4u w = qp[i];
#pragma unroll
              for (int e = 0; e < 4; ++e) { q[8 * i + 2 * e] = bf_lo(w[e]); q[8 * i + 2 * e + 1] = bf_hi(w[e]); } } }
#pragma unroll
        for (int d = 0; d < 64; ++d) o[d] = 0.f;
#define NA_KEY(KROW, BIAS) do { const size_t ko_ = (size_t)(KROW) * D + h * HD; const GAS v4u* kp_ = (const GAS v4u*)(Kb + ko_); const GAS v4u* vp_ = (const GAS v4u*)(Vb + ko_); \
        float s_ = (BIAS); \
        _Pragma("unroll") for (int i = 0; i < 8; ++i) { const v4u w = kp_[i]; \
            _Pragma("unroll") for (int e = 0; e < 4; ++e) { s_ += q[8 * i + 2 * e] * bf_lo(w[e]); s_ += q[8 * i + 2 * e + 1] * bf_hi(w[e]); } } \
        const float mn_ = fmaxf(mx, s_), f_ = __builtin_amdgcn_exp2f(mx - mn_), p_ = __builtin_amdgcn_exp2f(s_ - mn_); l = l * f_ + p_; mx = mn_; \
        _Pragma("unroll") for (int i = 0; i < 8; ++i) { const v4u w = vp_[i]; \
            _Pragma("unroll") for (int e = 0; e < 4; ++e) { o[8 * i + 2 * e] = o[8 * i + 2 * e] * f_ + p_ * bf_lo(w[e]); o[8 * i + 2 * e + 1] = o[8 * i + 2 * e + 1] * f_ + p_ * bf_hi(w[e]); } } } while (0)
        for (int j = 0; j < LC; ++j) NA_KEY(M_LAT + b * LC + j, 0.f);
        const int rs = min(max(r - 4, 0), GROWS - 8), cs = min(max(c - 8, 0), GW - 16);
        for (int i = 0; i < 8; ++i) { const float* brow = F.rpb + ((size_t)h * 15 + (rs + i - r + 7)) * 31 + (cs - c + 15);
            for (int jj = 0; jj < 16; ++jj) NA_KEY((size_t)b * SEQ + (rs + i) * GW + cs + jj, brow[jj] * LOG2E); }
#undef NA_KEY
        const float inv = 1.0f / l;
        const GAS v4u* zp = (const GAS v4u*)(Zb + qoff); GAS v4u* op = (GAS v4u*)(Ob + qoff);
#pragma unroll
        for (int i = 0; i < 8; ++i) { const v4u z = zp[i]; v4u w;
#pragma unroll
            for (int e = 0; e < 4; ++e) w[e] = pk2(o[8 * i + 2 * e] * inv * silu_f(bf_lo(z[e])), o[8 * i + 2 * e + 1] * inv * silu_f(bf_hi(z[e])));
            op[i] = w; }
    }
}

namespace na {
typedef short bf16x8 __attribute__((ext_vector_type(8)));
typedef short s16x4 __attribute__((ext_vector_type(4)));
typedef float f32x16 __attribute__((ext_vector_type(16)));
typedef short v4i16_t __attribute__((ext_vector_type(4)));
typedef float f32x2_t __attribute__((ext_vector_type(2))); typedef __bf16 bf16x2_t __attribute__((ext_vector_type(2)));
constexpr int KSLOT = 8192, VSUB = 4160, VSLOT = 2 * VSUB, SLOT = KSLOT + VSLOT;
constexpr int NUNITS = NB * NH * (GROWS / 4);
constexpr int L_TBL = 4 * SLOT, L_WSF = L_TBL + 16 * 64 * 4, L_STG = L_WSF + 8 * 256, L_END = L_STG + 8 * 4096;
static_assert(L_END <= RING_BYTES && (SLOT % 16) == 0 && (L_TBL % 16) == 0, "attention LDS map");
#ifndef NA_THR
#define NA_THR 8.0f
#endif
__device__ __forceinline__ int crow(int r, int hi) { return (r & 3) + 8 * (r >> 2) + 4 * hi; }
__device__ __forceinline__ unsigned cvtpk(float lo, float hi) { f32x2_t v = {lo, hi}; bf16x2_t b = __builtin_convertvector(v, bf16x2_t); return __builtin_bit_cast(unsigned, b); }
__device__ __forceinline__ s16x4 vtr(const LAS unsigned char* p) { return __builtin_bit_cast(s16x4, __builtin_amdgcn_ds_read_tr16_b64_v4i16((LAS v4i16_t*)p)); }
__device__ __forceinline__ float half_swap_max(float v) { auto rr = __builtin_amdgcn_permlane32_swap(__float_as_uint(v), __float_as_uint(v), false, false); return fmaxf(__uint_as_float(rr[0]), __uint_as_float(rr[1])); }
__device__ __forceinline__ float half_swap_sum(float v) { auto rr = __builtin_amdgcn_permlane32_swap(__float_as_uint(v), __float_as_uint(v), false, false); return __uint_as_float(rr[0]) + __uint_as_float(rr[1]); }

__device__ __forceinline__ void block32(f32x16& o0, f32x16& o1, float& m, float& l, const bf16x8 (&q)[4], f32x16 s,
                                        const LAS unsigned char* kb, int kx, const LAS unsigned char* vb, LAS float* wsf, int r32, int hi) {
#pragma unroll
    for (int d0 = 0; d0 < 4; ++d0) { const bf16x8 kf = *(const LAS bf16x8*)(kb + (((2 * d0 + hi) ^ kx) << 4)); s = __builtin_amdgcn_mfma_f32_32x32x16_bf16(kf, q[d0], s, 0, 0, 0); }
    float bm = fmaxf(fmaxf(s[0], s[1]), fmaxf(s[2], s[3]));
#pragma unroll
    for (int r = 4; r < 16; r += 4) bm = fmaxf(bm, fmaxf(fmaxf(s[r], s[r + 1]), fmaxf(s[r + 2], s[r + 3])));
    bm = half_swap_max(bm);
    if (__any(bm > m + NA_THR)) {
        const float mn = fmaxf(m, bm), f = __builtin_amdgcn_exp2f(m - mn);
        l *= f; m = mn;
        if (hi == 0) wsf[r32] = f;
        asm volatile("s_waitcnt lgkmcnt(0)" ::: "memory");
#pragma unroll
        for (int r = 0; r < 16; ++r) { const float fr = wsf[crow(r, hi)]; o0[r] *= fr; o1[r] *= fr; }
    }
    float ps = 0.f; unsigned pw[8];
#pragma unroll
    for (int r = 0; r < 16; r += 2) { const float p0 = __builtin_amdgcn_exp2f(s[r] - m), p1 = __builtin_amdgcn_exp2f(s[r + 1] - m); ps += p0 + p1; pw[r >> 1] = cvtpk(p0, p1); }
    l += ps;
#pragma unroll
    for (int ks = 0; ks < 2; ++ks) {
        const bf16x8 pa = __builtin_bit_cast(bf16x8, (v4u){pw[4 * ks], pw[4 * ks + 1], pw[4 * ks + 2], pw[4 * ks + 3]});
#pragma unroll
        for (int dh = 0; dh < 2; ++dh) {
            const s16x4 lo = vtr(vb + dh * VSUB + ks * 1024), hh = vtr(vb + dh * VSUB + ks * 1024 + 512);
            const bf16x8 vf = (bf16x8){lo[0], lo[1], lo[2], lo[3], hh[0], hh[1], hh[2], hh[3]};
            if (dh == 0) o0 = __builtin_amdgcn_mfma_f32_32x32x16_bf16(pa, vf, o0, 0, 0, 0); else o1 = __builtin_amdgcn_mfma_f32_32x32x16_bf16(pa, vf, o1, 0, 0, 0);
        }
    }
}
__device__ __forceinline__ void finish_tile(const f32x16& o0, const f32x16& o1, float l, const bf16* Zb, bf16* Ob, size_t tok0  , int h,
                                            LAS float* wsf, LAS unsigned short* stg, int lane, int r32, int hi) {
    l = half_swap_sum(l);
    if (hi == 0) wsf[32 + r32] = l;
    asm volatile("s_waitcnt lgkmcnt(0)" ::: "memory");
#pragma unroll
    for (int r = 0; r < 16; ++r) { const float rl = __builtin_amdgcn_rcpf(wsf[32 + crow(r, hi)]); const int orow = crow(r, hi);
        stg[orow * 64 + r32] = (unsigned short)f2bf(o0[r] * rl); stg[orow * 64 + 32 + r32] = (unsigned short)f2bf(o1[r] * rl); }
    asm volatile("s_waitcnt lgkmcnt(0)" ::: "memory");
#pragma unroll
    for (int i = 0; i < 4; ++i) { const int row = i * 8 + (lane >> 3), ch = lane & 7;
        const size_t off = (tok0 + (size_t)(row >> 4) * GW + (row & 15)) * D + h * HD + ch * 8;
        const v4u ov = *(const LAS v4u*)(stg + row * 64 + ch * 8); const v4u z = *(const GAS v4u*)(Zb + off); v4u w;
#pragma unroll
        for (int e = 0; e < 4; ++e) w[e] = pk2(bf_lo(ov[e]) * silu_f(bf_lo(z[e])), bf_hi(ov[e]) * silu_f(bf_hi(z[e])));
        *(GAS v4u*)(Ob + off) = w; }
    asm volatile("s_waitcnt lgkmcnt(0)" ::: "memory");
}
__device__ __forceinline__ int rs_of(int r) { return min(max(r - 4, 0), GROWS - 8); }

__device__ __forceinline__ void phase(Frame& F) {
    const bf16 *Qb = F.R1, *Kb = F.R2, *Vb = F.R3, *Zb = F.R4; bf16* Ob = F.H;
    LAS unsigned char* lds = F.lds + RING_OFF;
    const int tid = F.tid, lane = F.lane, wid = F.wave, r32 = lane & 31, hi = lane >> 5, cb = wid & 3, rp = wid >> 2;
    LAS float* tbl = (LAS float*)(lds + L_TBL); LAS float* wsf = (LAS float*)(lds + L_WSF) + wid * 64; LAS unsigned short* stg = (LAS unsigned short*)(lds + L_STG) + wid * 2048;
    const int w0 = min(max(16 * cb - 8, 0), 32);
    const int c = 16 * cb + (r32 & 15), cs = min(max(c - 8, 0), GW - 16);
    f32x16 addmask;
#pragma unroll
    for (int r = 0; r < 16; ++r) { const int kc = w0 + crow(r, hi); addmask[r] = (kc >= cs && kc <= cs + 15) ? 0.f : -INFINITY; }
    const int dcb = 16 + w0 + 4 * hi - c + 15;
    const int kx = r32 & 7;
    const int skey = tid >> 3, sch = tid & 7;
    const unsigned kst = (unsigned)(skey * 128 + ((sch ^ (skey & 7)) << 4)), vst = (unsigned)(KSLOT + (sch >> 2) * VSUB + skey * 64 + (sch & 3) * 16);
    const int upc = (NUNITS + F.G - 1) / F.G;
    for (int ui = 0; ui < upc; ++ui) {
        const int unit = F.vcu * upc + ui; if (unit >= NUNITS) break;
        const int rg = unit & 31, h = (unit >> 5) & 15, b = unit >> 9;
        const int rlo = rs_of(4 * rg), rhi = rs_of(4 * rg + 3) + 7, nb = rhi - rlo + 1, T = 4 + nb, nst = (T + 1) >> 1;
        for (int i = tid; i < 16 * 64; i += NWAVES * 64) { const int dr = i >> 6, dc = (i & 63) - 16; float v = 0.f;
            if (dr == 15) v = -INFINITY; else if (dc >= 0 && dc <= 30) v = F.rpb[((size_t)h * 15 + dr) * 31 + dc] * LOG2E;
            tbl[i] = v; }
        const size_t srcoff = (size_t)skey * D + h * HD + sch * 8;
#define TILE_ROW0(t) ((t) < 4 ? (size_t)M_LAT + (size_t)b * LC + 64 * (t) : (size_t)b * SEQ + (size_t)(rlo + (t) - 4) * GW)
        v4u kreg0, vreg0, kreg1, vreg1;
        { const size_t o0 = TILE_ROW0(0) * D + srcoff, o1 = TILE_ROW0(1) * D + srcoff;
          kreg0 = *(const GAS v4u*)(Kb + o0); vreg0 = *(const GAS v4u*)(Vb + o0); kreg1 = *(const GAS v4u*)(Kb + o1); vreg1 = *(const GAS v4u*)(Vb + o1); }
        const int ra = 4 * rg + 2 * rp;
        bf16x8 qa[4];
        { const size_t ta = ((size_t)b * SEQ + (size_t)(ra + (r32 >> 4)) * GW + c) * D + h * HD + 8 * hi;
#pragma unroll
          for (int d0 = 0; d0 < 4; ++d0) qa[d0] = *(const GAS bf16x8*)(Qb + ta + 16 * d0); }
        f32x16 oa0, oa1;
#pragma unroll
        for (int r = 0; r < 16; ++r) { oa0[r] = 0.f; oa1[r] = 0.f; }
        float ma = -INFINITY, la = 0.f;
        *(LAS v4u*)(lds + kst) = kreg0; *(LAS v4u*)(lds + vst) = vreg0; *(LAS v4u*)(lds + SLOT + kst) = kreg1; *(LAS v4u*)(lds + SLOT + vst) = vreg1;
        __syncthreads();
        const int alo = rs_of(ra), ahi = rs_of(ra + 1) + 7;
        const int rq = ra + (r32 >> 4), qlo = rs_of(rq), qhi = qlo + 7;
        for (int st = 0; st < nst; ++st) {
            const LAS unsigned char* buf = lds + (st & 1) * (2 * SLOT);
            const bool more = st + 1 < nst, more1 = 2 * st + 3 < T;
            if (more) { const size_t o0 = TILE_ROW0(2 * st + 2) * D + srcoff; kreg0 = *(const GAS v4u*)(Kb + o0); vreg0 = *(const GAS v4u*)(Vb + o0);
                if (more1) { const size_t o1 = TILE_ROW0(2 * st + 3) * D + srcoff; kreg1 = *(const GAS v4u*)(Kb + o1); vreg1 = *(const GAS v4u*)(Vb + o1); } }
#pragma unroll
            for (int j = 0; j < 2; ++j) {
                const int t = 2 * st + j; if (t >= T) break;
                const LAS unsigned char* slot = buf + j * SLOT;
                if (t < 4) {
                    f32x16 z16;
#pragma unroll
                    for (int r = 0; r < 16; ++r) z16[r] = 0.f;
#pragma unroll
                    for (int kh = 0; kh < 2; ++kh) {
                        const LAS unsigned char* kbp = slot + (32 * kh + r32) * 128;
                        const LAS unsigned char* vbp = slot + KSLOT + (32 * kh + 4 * hi + ((lane & 15) >> 2)) * 64 + ((lane >> 4) & 1) * 32 + (lane & 3) * 8;
                        block32(oa0, oa1, ma, la, qa, z16, kbp, kx, vbp, wsf, r32, hi);
                    }
                } else {
                    const int rho = rlo + t - 4;
                    if (rho >= alo && rho <= ahi) {
                        const LAS unsigned char* kbp = slot + (w0 + r32) * 128;
                        const LAS unsigned char* vbp = slot + KSLOT + (w0 + 4 * hi + ((lane & 15) >> 2)) * 64 + ((lane >> 4) & 1) * 32 + (lane & 3) * 8;
                        const int dre = (rho >= qlo && rho <= qhi) ? (rho - rq + 7) : 15;
                        const LAS float* trow = tbl + dre * 64 + dcb; f32x16 ci;
#pragma unroll
                        for (int q = 0; q < 16; ++q) ci[q] = trow[(q & 3) + 8 * (q >> 2)] + addmask[q];
                        block32(oa0, oa1, ma, la, qa, ci, kbp, kx, vbp, wsf, r32, hi);
                    }
                }
            }
            if (more) { LAS unsigned char* ns = lds + ((st + 1) & 1) * (2 * SLOT); *(LAS v4u*)(ns + kst) = kreg0; *(LAS v4u*)(ns + vst) = vreg0;
                if (more1) { *(LAS v4u*)(ns + SLOT + kst) = kreg1; *(LAS v4u*)(ns + SLOT + vst) = vreg1; } }
            __syncthreads();
        }
#undef TILE_ROW0
        finish_tile(oa0, oa1, la, Zb, Ob, (size_t)b * SEQ + (size_t)ra * GW + 16 * cb, h, wsf, stg, lane, r32, hi);
        __syncthreads();
    }
}
}
struct Args { const float* in[14]; float* out; unsigned char* ws; int ph_lo, ph_hi, li, pad; };
__global__ void __launch_bounds__(NWAVES * 64, 2) skel_fwd(Args args) {
    extern __shared__ __attribute__((aligned(16))) unsigned char lds[];
    Frame F;
    F.lds = (LAS unsigned char*)lds;
    F.MISC = (volatile LAS unsigned*)(F.lds + MISC_OFF);
    F.tid = threadIdx.x; F.lane = F.tid & 63; F.wave = __builtin_amdgcn_readfirstlane(F.tid >> 6);
    F.G = gridDim.x; { const int bx = blockIdx.x; F.vcu = (F.G % 8 == 0) ? (bx % 8) * (F.G / 8) + bx / 8 : bx; }
#define GRID_BAR(seam) do { if (N_LAUNCHES != 1) { if (F.tid == 0) __hip_atomic_store(F.ctl + CW_TMO, 0xBADBA0u | (unsigned)(seam), RLX_AGENT); } \
    else { xcd_barrier(bar); } } while (0)
    unsigned char* ws = args.ws;
    F.ctl = (gu32*)(ws + WS_CTL);
    F.x = args.in[0]; F.c = args.in[1]; F.ctx = args.in[2]; F.c_ctx = args.in[3]; F.g_pre = args.in[4]; F.g_post = args.in[5]; F.w_mod = args.in[6]; F.b_mod = args.in[7];
    F.w_in_conv = args.in[8]; F.conv_w = args.in[9]; F.w_out_conv = args.in[10]; F.w_in_na = args.in[11]; F.rpb = args.in[12]; F.w_out_na = args.in[13]; F.out = args.out;
    F.MOD = (float*)(ws + WS_MOD); F.W1T = (bf16*)(ws + WS_W1T); F.W2T = (bf16*)(ws + WS_W2T); F.W3T = (bf16*)(ws + WS_W3T); F.W4T = (bf16*)(ws + WS_W4T);
    F.H = (bf16*)(ws + WS_H); F.R1 = (bf16*)(ws + WS_R1); F.R2 = (bf16*)(ws + WS_R2); F.R3 = (bf16*)(ws + WS_R3); F.R4 = (bf16*)(ws + WS_R4); F.X1 = (float*)(ws + WS_X1);
    for (int u = F.tid; u < (LDS_BYTES - LDSCTL_OFF) / 4; u += NWAVES * 64) ((LAS unsigned*)(F.lds + LDSCTL_OFF))[u] = 0u;
    __syncthreads();
    XcdBarrier bar; bar.bar = (unsigned*)(F.ctl + CW_BAR); bar.x = 0; bar.st = nullptr;
    if (N_LAUNCHES == 1) bar = xcd_barrier_post((unsigned*)(F.ctl + CW_BAR), F.MISC + 8);

    const int lo = args.ph_lo, hi = args.ph_hi;
#define IN(k) (lo <= (k) && (k) < hi)
#define BOTH(k) (IN(k) && IN((k) + 1))
    if (IN(0)) { p0_prologue(F); if (BOTH(0)) GRID_BAR(0); }
    if (IN(1)) { p1_h0(F); if (BOTH(1)) GRID_BAR(1); }
    if (IN(2)) {
        pg8::Gemm g{F.H, F.W1T, M_ALL, N4, D}; pg8::StaticOrder S; S.init(M_ALL, N4, F.G, (int)blockIdx.x);
        pg8::EpiGate E{F.R1, F.R2};
        pg8::gemm_phase<pg8::EpiGate, pg8::StaticOrder, PG8_ALIGN, PG8_SP2>(F.lds + RING_OFF, g, S, E);
        if (BOTH(2)) GRID_BAR(2);
    }
    if (IN(3)) { p3_conv(F); if (BOTH(3)) GRID_BAR(3); }
    if (IN(4)) {
        pg8::Gemm g{F.R3, F.W2T, M_ALL, D, D}; pg8::StaticOrder S; S.init(M_ALL, D, F.G, (int)blockIdx.x);
        pg8::EpiF32 E{(float*)F.R1, D};
        pg8::gemm_phase<pg8::EpiF32, pg8::StaticOrder, PG8_ALIGN, PG8_SP2>(F.lds + RING_OFF, g, S, E);
        if (BOTH(4)) GRID_BAR(4);
    }
    if (IN(5)) { p5_mid(F); if (BOTH(5)) GRID_BAR(5); }
    if (IN(6)) {
        pg8::Gemm g{F.H, F.W3T, M_ALL, N4, D}; pg8::StaticOrder S; S.init(M_ALL, N4, F.G, (int)blockIdx.x);
        pg8::EpiBf16Split E{F.R1, D, D, RSZ / 2, QSCALE};
        pg8::gemm_phase<pg8::EpiBf16Split, pg8::StaticOrder, PG8_ALIGN, PG8_SP2>(F.lds + RING_OFF, g, S, E);
        if (BOTH(6)) GRID_BAR(6);
    }
    if (IN(7)) { na::phase(F); if (BOTH(7)) GRID_BAR(7); }
    if (IN(8)) {
        pg8::Gemm g{F.H, F.W4T, M_LAT, D, D}; pg8::StaticOrder S; S.init(M_LAT, D, F.G, (int)blockIdx.x);
        pg8::EpiF32 E{(float*)F.R1, D};
        pg8::gemm_phase<pg8::EpiF32, pg8::StaticOrder, PG8_ALIGN, PG8_SP2>(F.lds + RING_OFF, g, S, E);
        if (BOTH(8)) GRID_BAR(8);
    }
    if (IN(9)) { p9_final(F); }
#undef IN
#undef BOTH
}

extern "C" void kernel_launch(void* const* d_in, const int* in_sizes, int n_in, void* d_out, int out_size, void* d_ws, size_t ws_size, hipStream_t stream) {
    static int grid = 0;
    if (grid == 0) {
        if (n_in != 14 || in_sizes[0] != M_LAT * D || out_size != M_LAT * D || ws_size < WS_END) { fprintf(stderr, "kernel_launch: unexpected shapes (n_in %d, in0 %d, out %d, ws %zu < %zu); nothing launched\n", n_in, n_in > 0 ? in_sizes[0] : -1, out_size, ws_size, (size_t)WS_END); grid = -1; return; }
        int dev = 0, cus = 0, per_cu = 0;
        if (hipGetDevice(&dev) != hipSuccess || hipDeviceGetAttribute(&cus, hipDeviceAttributeMultiprocessorCount, dev) != hipSuccess) { grid = -1; return; }
        if (hipFuncSetAttribute((const void*)skel_fwd, hipFuncAttributeMaxDynamicSharedMemorySize, LDS_BYTES) != hipSuccess) { fprintf(stderr, "kernel_launch: hipFuncSetAttribute failed\n"); grid = -1; return; }
        if (hipOccupancyMaxActiveBlocksPerMultiprocessor(&per_cu, (const void*)skel_fwd, NWAVES * 64, LDS_BYTES) != hipSuccess || per_cu < 1)
            fprintf(stderr, "kernel_launch: note: occupancy query reports %d workgroups per CU\n", per_cu);
        (void)hipGetLastError();
        grid = cus;
    }
    if (grid < 0) return;
    if (hipMemsetAsync((char*)d_ws + WS_CTL, 0, CTL_ZERO_BYTES, stream) != hipSuccess) return;
    Args a{};
    for (int i = 0; i < 14; ++i) a.in[i] = (const float*)d_in[i];
    a.out = (float*)d_out; a.ws = (unsigned char*)d_ws;
    for (int li = 0; li < N_LAUNCHES; ++li) {
        a.ph_lo = (N_LAUNCHES == 1) ? 0 : li; a.ph_hi = (N_LAUNCHES == 1) ? N_PHASES : li + 1; a.li = li;
        hipLaunchKernelGGL(skel_fwd, dim3(grid), dim3(NWAVES * 64), LDS_BYTES, stream, a);
        if (hipPeekAtLastError() != hipSuccess) break;
    }
}
```
